# Optimizing an MI355X kernel written in HIP

```python
import jax, jax.numpy as jnp
from jax import lax
import numpy as np

D_MODEL = 1024
BATCH = 8
SEQ = 4096
DEPTH = 4

GRID_W = 64
CTX_LEN = 256
N_MIXERS = 2
N_HGRN_LAYERS = (DEPTH + 1) // 2
N_MLA_LAYERS = DEPTH // 2
FFN_HIDDEN = 2816
N_MOD = 9
RMS_EPS = 1e-6
HG_HEADS = 8
HG_DK = 128
HG_DV = D_MODEL // HG_HEADS
HG_CHUNK = 32
HG_HK = HG_HEADS * HG_DK
HG_HV = HG_HEADS * HG_DV
HG_IN = 3 * HG_HK + HG_HV + D_MODEL
F_MIN = 1e-6
MLA_HEADS = 8
MLA_NOPE = 128
MLA_ROPE = 64
MLA_V = 128
Q_LORA = 384
KV_LORA = 256
MLA_QK = MLA_NOPE + MLA_ROPE
MLA_DOWN = Q_LORA + KV_LORA + MLA_ROPE
MLA_SCALE = MLA_QK ** -0.5
Q_BLOCK = 128
ROPE_BASE = 10000.0

kernel_name = "hybrid_hgrn2_mla_macaron_prefix_dit"


def rms_norm(x, g):
    xf = x.astype(jnp.float32)
    y = xf * lax.rsqrt(jnp.mean(xf * xf, axis=-1, keepdims=True) + RMS_EPS)
    return (y * g.astype(jnp.float32)).astype(x.dtype)


def modulate(h, shift, scale):
    return h * (1 + scale) + shift


def swiglu(h, w_gate, w_up, w_down):
    return (jax.nn.silu(h @ w_gate) * (h @ w_up)) @ w_down


def ffn_half(h, mod, base, g, w_gate, w_up, w_down):
    a = modulate(rms_norm(h, g), mod[:, base], mod[:, base + 1])
    return h + 0.5 * mod[:, base + 2] * swiglu(a, w_gate, w_up, w_down)


def axial_rope_tables(n_tokens):
    rows = n_tokens // GRID_W
    row = jnp.repeat(jnp.arange(rows), GRID_W).astype(jnp.float32)
    col = jnp.tile(jnp.arange(GRID_W), rows).astype(jnp.float32)
    axis_dims = MLA_ROPE // 2
    inv = 1.0 / (ROPE_BASE ** (jnp.arange(0, axis_dims, 2, dtype=jnp.float32) / axis_dims))
    ang = jnp.stack([row[:, None] * inv, col[:, None] * inv], axis=1)
    return jnp.cos(ang), jnp.sin(ang)


def apply_axial_rope(x, cos, sin):
    xr = x.reshape(x.shape[:-1] + (2, 2, MLA_ROPE // 4))
    a, b = xr[..., 0, :], xr[..., 1, :]
    cos = cos.astype(x.dtype)
    sin = sin.astype(x.dtype)
    out = jnp.stack([a * cos - b * sin, a * sin + b * cos], axis=-2)
    return out.reshape(x.shape)


def _heads(a, d):
    b_, t_, _ = a.shape
    return a.reshape(b_, t_, -1, d).transpose(0, 2, 1, 3)


def hgrn2_chunk_scan(q, k, v, logf, s0, with_output):
    b_, h_, t_, dk = q.shape
    n = t_ // HG_CHUNK

    def chunks(a):
        return jnp.moveaxis(a.reshape(b_, h_, n, HG_CHUNK, a.shape[-1]), 2, 0)

    causal = jnp.tril(jnp.ones((HG_CHUNK, HG_CHUNK), dtype=bool))[:, :, None]
    causal_f = causal.astype(jnp.float32)

    def step(s, inp):
        qb, kb, vb, gb = inp
        cum = jnp.cumsum(gb, axis=2)
        cum_last = cum[:, :, -1:, :]
        k_end = kb * jnp.exp(cum_last - cum)
        s_new = jnp.exp(cum_last)[:, :, 0, :, None] * s + jnp.einsum('bhck,bhcv->bhkv', k_end, vb)
        if not with_output:
            return s_new, None
        diff = cum[:, :, :, None, :] - cum[:, :, None, :, :]
        decay = jnp.exp(jnp.where(causal, diff, 0.0)) * causal_f
        scores = jnp.einsum('bhtk,bhtsk,bhsk->bhts', qb, decay, kb)
        o = jnp.einsum('bhtk,bhkv->bhtv', qb * jnp.exp(cum), s) + jnp.einsum('bhts,bhsv->bhtv', scores, vb)
        return s_new, o

    s_fin, o = lax.scan(step, s0, (chunks(q), chunks(k), chunks(v), chunks(logf)))
    if with_output:
        o = jnp.moveaxis(o, 0, 2).reshape(b_, h_, t_, v.shape[-1])
    return s_fin, o


def hgrn2_inputs(a, w_in, lb):
    p = a @ w_in
    q, z_f, z_b, i, g = jnp.split(p, [HG_HK, 2 * HG_HK, 3 * HG_HK, 3 * HG_HK + HG_HV], axis=-1)
    q = _heads(q, HG_DK).astype(jnp.float32)
    v = _heads(i, HG_DV).astype(jnp.float32)
    dirs = []
    for d, z in enumerate((z_f, z_b)):
        zf = _heads(z, HG_DK).astype(jnp.float32)
        lbd = lb[d].reshape(HG_HEADS, 1, HG_DK)
        f = lbd + (1 - lbd) * jax.nn.sigmoid(zf)
        logf = jnp.log(jnp.maximum(f, F_MIN))
        k = (1 - lbd) * jax.nn.sigmoid(-zf)
        dirs.append((k, logf))
    return q, v, dirs[0], dirs[1], g


def hgrn2_mixer(u, uc, w_in, w_out, gn, lb, with_ctx_out):
    q, v, (kf, gf), (kb, gb), g = hgrn2_inputs(u, w_in, lb)
    qc, vc, (kcf, gcf), (kcb, gcb), gc = hgrn2_inputs(uc, w_in, lb)
    zero = jnp.zeros((u.shape[0], HG_HEADS, HG_DK, HG_DV), jnp.float32)
    flip = lambda a: jnp.flip(a, axis=2)
    s_cf, o_cf = hgrn2_chunk_scan(qc, kcf, vc, gcf, zero, with_ctx_out)
    s_cb, o_cb = hgrn2_chunk_scan(flip(qc), flip(kcb), flip(vc), flip(gcb), zero, with_ctx_out)
    _, o_f = hgrn2_chunk_scan(q, kf, v, gf, s_cf, True)
    _, o_b = hgrn2_chunk_scan(flip(q), flip(kb), flip(v), flip(gb), s_cb, True)

    def readout(o, gate):
        o = rms_norm(o, gn)
        b_, h_, t_, dv = o.shape
        o = o.transpose(0, 2, 1, 3).reshape(b_, t_, h_ * dv).astype(gate.dtype)
        return (o * jax.nn.silu(gate)) @ w_out

    y = readout(o_f + flip(o_b), g)
    yc = readout(o_cf + flip(o_cb), gc) if with_ctx_out else None
    return y, yc


def mla_project(a, w_down, q_norm, w_uq, kv_norm, w_ukv, rope):
    b_, t_, _ = a.shape
    dproj = a @ w_down
    cq, ckv, kr = jnp.split(dproj, [Q_LORA, Q_LORA + KV_LORA], axis=-1)
    q = (rms_norm(cq, q_norm) @ w_uq).reshape(b_, t_, MLA_HEADS, MLA_QK)
    kv = (rms_norm(ckv, kv_norm) @ w_ukv).reshape(b_, t_, MLA_HEADS, MLA_NOPE + MLA_V)
    q_nope, q_rope = jnp.split(q, [MLA_NOPE], axis=-1)
    k_nope, v = jnp.split(kv, [MLA_NOPE], axis=-1)
    if rope is not None:
        cos, sin = rope
        q_rope = apply_axial_rope(q_rope, cos[:, None], sin[:, None])
        kr = apply_axial_rope(kr, cos, sin)
    k_rope = jnp.broadcast_to(kr[:, :, None, :], (b_, t_, MLA_HEADS, MLA_ROPE))
    q = jnp.concatenate([q_nope, q_rope], axis=-1)
    k = jnp.concatenate([k_nope, k_rope], axis=-1)
    return q, k, v


def attend(q, k, v):
    s = jnp.einsum('bqhd,bkhd->bhqk', q, k).astype(jnp.float32) * MLA_SCALE
    p = jax.nn.softmax(s, axis=-1).astype(v.dtype)
    return jnp.einsum('bhqk,bkhd->bqhd', p, v)


def mla_mixer(u, uc, w_down, q_norm, w_uq, kv_norm, w_ukv, w_o, cos, sin, with_ctx_out):
    b_, t_, _ = u.shape
    q, k, v = mla_project(u, w_down, q_norm, w_uq, kv_norm, w_ukv, (cos, sin))
    qc, kc, vc = mla_project(uc, w_down, q_norm, w_uq, kv_norm, w_ukv, None)
    k_all = jnp.concatenate([k, kc], axis=1)
    v_all = jnp.concatenate([v, vc], axis=1)
    nb = t_ // Q_BLOCK
    qb = jnp.moveaxis(q.reshape(b_, nb, Q_BLOCK, MLA_HEADS, MLA_QK), 1, 0)
    ob = lax.map(lambda blk: attend(blk, k_all, v_all), qb)
    o = jnp.moveaxis(ob, 0, 1).reshape(b_, t_, MLA_HEADS * MLA_V)
    y = o @ w_o
    yc = attend(qc, kc, vc).reshape(b_, uc.shape[1], MLA_HEADS * MLA_V) @ w_o if with_ctx_out else None
    return y, yc


def setup_inputs(seed: int = 0) -> dict:
    key = jax.random.key(seed)
    ks = jax.random.split(key, 24)
    nrm = lambda k, shape, s: jax.random.normal(k, shape, jnp.float32) * s
    D = D_MODEL
    return {
        'x': nrm(ks[0], (BATCH, SEQ, D), 1.0),
        'c': nrm(ks[1], (BATCH, D), 1.0),
        'ctx': nrm(ks[2], (BATCH, CTX_LEN, D), 1.0),
        'c_ctx': nrm(ks[3], (D,), 1.0),
        'mod_w': nrm(ks[4], (DEPTH, D, N_MOD * D), 0.5 * D ** -0.5),
        'mod_b': nrm(ks[5], (DEPTH, N_MOD * D), 0.01),
        'norm_g': 1.0 + nrm(ks[6], (DEPTH, 3, D), 0.02),
        'ffn_w_gate': nrm(ks[7], (DEPTH, 2, D, FFN_HIDDEN), D ** -0.5),
        'ffn_w_up': nrm(ks[8], (DEPTH, 2, D, FFN_HIDDEN), D ** -0.5),
        'ffn_w_down': nrm(ks[9], (DEPTH, 2, FFN_HIDDEN, D), FFN_HIDDEN ** -0.5),
        'hg_w_in': nrm(ks[10], (N_HGRN_LAYERS, D, HG_IN), D ** -0.5),
        'hg_w_out': nrm(ks[11], (N_HGRN_LAYERS, HG_HV, D), HG_HV ** -0.5),
        'hg_gn': 1.0 + nrm(ks[12], (N_HGRN_LAYERS, HG_DV), 0.02),
        'hg_lb_logits': nrm(ks[13], (N_HGRN_LAYERS, 2, HG_HK), 0.5),
        'mla_w_down': nrm(ks[14], (N_MLA_LAYERS, D, MLA_DOWN), D ** -0.5),
        'mla_q_norm': 1.0 + nrm(ks[15], (N_MLA_LAYERS, Q_LORA), 0.02),
        'mla_w_uq': nrm(ks[16], (N_MLA_LAYERS, Q_LORA, MLA_HEADS * MLA_QK), Q_LORA ** -0.5),
        'mla_kv_norm': 1.0 + nrm(ks[17], (N_MLA_LAYERS, KV_LORA), 0.02),
        'mla_w_ukv': nrm(ks[18], (N_MLA_LAYERS, KV_LORA, MLA_HEADS * (MLA_NOPE + MLA_V)), KV_LORA ** -0.5),
        'mla_w_o': nrm(ks[19], (N_MLA_LAYERS, MLA_HEADS * MLA_V, D), (MLA_HEADS * MLA_V) ** -0.5),
        'final_g': 1.0 + nrm(ks[20], (D,), 0.02),
    }


def reference(x, c, ctx, c_ctx, mod_w, mod_b, norm_g, ffn_w_gate, ffn_w_up, ffn_w_down,
              hg_w_in, hg_w_out, hg_gn, hg_lb_logits, mla_w_down, mla_q_norm, mla_w_uq,
              mla_kv_norm, mla_w_ukv, mla_w_o, final_g):
    n_tok = x.shape[1]
    cos, sin = axial_rope_tables(n_tok)
    p_lb = jax.nn.softmax(hg_lb_logits.astype(jnp.float32), axis=0)
    lbs = jnp.maximum(jnp.cumsum(p_lb, axis=0) - p_lb[0:1], 0.0)
    sc = jax.nn.silu(c)
    scc = jax.nn.silu(c_ctx)[None]
    h, hc = x, ctx
    for i in range(DEPTH):
        last = i == DEPTH - 1
        mod = (sc @ mod_w[i] + mod_b[i]).reshape(-1, N_MOD, 1, D_MODEL)
        modc = (scc @ mod_w[i] + mod_b[i]).reshape(-1, N_MOD, 1, D_MODEL)
        h = ffn_half(h, mod, 0, norm_g[i, 0], ffn_w_gate[i, 0], ffn_w_up[i, 0], ffn_w_down[i, 0])
        hc = ffn_half(hc, modc, 0, norm_g[i, 0], ffn_w_gate[i, 0], ffn_w_up[i, 0], ffn_w_down[i, 0])
        u = modulate(rms_norm(h, norm_g[i, 1]), mod[:, 3], mod[:, 4])
        uc = modulate(rms_norm(hc, norm_g[i, 1]), modc[:, 3], modc[:, 4])
        j = i // N_MIXERS
        if i % N_MIXERS == 0:
            y, yc = hgrn2_mixer(u, uc, hg_w_in[j], hg_w_out[j], hg_gn[j], lbs[j], not last)
        else:
            y, yc = mla_mixer(u, uc, mla_w_down[j], mla_q_norm[j], mla_w_uq[j], mla_kv_norm[j],
                              mla_w_ukv[j], mla_w_o[j], cos, sin, not last)
        h = h + mod[:, 5] * y
        h = ffn_half(h, mod, 6, norm_g[i, 2], ffn_w_gate[i, 1], ffn_w_up[i, 1], ffn_w_down[i, 1])
        if not last:
            hc = hc + modc[:, 5] * yc
            hc = ffn_half(hc, modc, 6, norm_g[i, 2], ffn_w_gate[i, 1], ffn_w_up[i, 1], ffn_w_down[i, 1])
    return rms_norm(h, final_g)
```

```cpp
#include <hip/hip_runtime.h>
#include <hip/hip_cooperative_groups.h>
#include <cstdio>
namespace cg = cooperative_groups;
namespace pg8 {
#define PG8_LAS __attribute__((address_space(3)))
typedef unsigned short bf16_t;
typedef short bf16x8 __attribute__((ext_vector_type(8)));
typedef float f32x4 __attribute__((ext_vector_type(4)));
typedef unsigned u32x4 __attribute__((ext_vector_type(4)));
constexpr int BM = 256, BK = 64, HALF = 128, HTB = HALF * BK * 2  , STAGE_BYTES = 8 * HTB, NXCD = 8, WGM = 8;

__host__ __device__ __forceinline__ int lds_byte(int r, int c) { const int st = (r >> 4) * 2 + (c >> 5), rr = r & 15, cc = c & 31, ob = rr * 64 + cc * 2; return st * 1024 + (ob ^ (((ob >> 9) & 1) << 5)); }
__host__ __device__ __forceinline__ void stage_rc(int b, int& R, int& C) { const int st = b / 1024, sb = b % 1024, swz = sb ^ (((sb >> 9) & 1) << 5); R = (st >> 1) * 16 + swz / 64; C = (st & 1) * 32 + (swz % 64) / 2; }
__host__ __device__ __forceinline__ int perm32(int rho) { const int n = rho >> 4, i = rho & 15; return 8 * (i >> 2) + 4 * n + (i & 3); }

struct Unit { int pm, pn; };
struct Gemm { const bf16_t* A; const bf16_t* Bt; int M, N, K; };

struct StaticOrder {
    int nM, nN, nwg, G, c;
    __host__ __device__ void init(int M, int N, int G_, int c_) { nM = M / BM; nN = N / BM; nwg = nM * nN; G = G_; c = c_; }
    __host__ __device__ bool next(int i, Unit& u) const {
        const long L = (long)i * G + c; if (L >= nwg) return false;
        int wgid = (int)L; { const int q = nwg / NXCD, r = nwg % NXCD, xcd = wgid % NXCD, off = wgid / NXCD; wgid = (xcd < r ? xcd * (q + 1) : r * (q + 1) + (xcd - r) * q) + off; }
        const int nig = WGM * nN, gid = wgid / nig, fm = gid * WGM, gsz = (nM - fm) < WGM ? (nM - fm) : WGM;
        u.pm = fm + ((wgid % nig) % gsz); u.pn = (wgid % nig) / gsz; return true;
    }
    __device__ __forceinline__ void a_ready(const Unit&) const {}
    __device__ __forceinline__ void done(const Unit&) const {}
};
__device__ __forceinline__ unsigned cvt_pk_bf16(float lo, float hi) { unsigned r; asm volatile("v_cvt_pk_bf16_f32 %0, %1, %2" : "=v"(r) : "v"(lo), "v"(hi)); return r; }
typedef float f32x2 __attribute__((ext_vector_type(2)));
template <class Epi, class Sched, bool STAMP = false>
__device__ __forceinline__ void gemm_phase(PG8_LAS unsigned char* lds, const Gemm g, const Sched& S, const Epi& E, unsigned long long* stamps) {
    int tid_ = threadIdx.x; asm volatile("" : "+v"(tid_)); const int tid = tid_, wid = __builtin_amdgcn_readfirstlane(tid >> 6), lane = tid & 63, wr = wid >> 2, wc = wid & 3, fr = lane & 15, fq = lane >> 4;
    const int K = g.K, nt = K / BK;
    int ts_lo = 0, ts_hi = 0, nts = 0; const unsigned long long rt_entry = STAMP ? (unsigned long long)wall_clock64() : 0ull;
#define PG8_STAMP() do { if (STAMP && wid == 0 && nts < 64) { const unsigned long long _c = (unsigned long long)clock64(); \
        ts_lo = (lane == nts) ? (int)(unsigned)_c : ts_lo; ts_hi = (lane == nts) ? (int)(unsigned)(_c >> 32) : ts_hi; ++nts; } } while (0)
    PG8_STAMP();
    unsigned voffA[2], voffB[2];
#pragma unroll
    for (int i = 0; i < 2; ++i) { int R, C; stage_rc(tid * 16 + i * 8192, R, C); const int Rb = Epi::PERM ? ((R & ~31) + perm32(R & 31)) : R;
        voffA[i] = (unsigned)(R * K + C) * 2u; voffB[i] = (unsigned)(Rb * K + C) * 2u; }
    const size_t kstep = (size_t)(BK * 2);
    const size_t hstep = (size_t)HALF * K * 2;
    const size_t tstep = 2 * hstep;
    const unsigned ldsw = (unsigned)wid * 1024u;
    const int aoff = lds_byte(wr * 64 + fr, fq * 8), boff = lds_byte(wc * 32 + fr, fq * 8);
#define PG8_SA(b, h) (((b) * 2 + (h)) * HTB)
#define PG8_SB(b, h) ((4 + (b) * 2 + (h)) * HTB)
#define PG8_STAGE(bufoff, gbase, voff) do { _Pragma("unroll") for (int _i = 0; _i < 2; ++_i) \
        __builtin_amdgcn_global_load_lds((const unsigned*)((const char*)(gbase) + (voff)[_i]), (PG8_LAS unsigned*)(lds + (bufoff) + ldsw + _i * 8192), 16, 0, 0); } while (0)
#define PG8_LDA(dst, b, h) do { _Pragma("unroll") for (int m = 0; m < 4; ++m) _Pragma("unroll") for (int k = 0; k < 2; ++k) dst[m][k] = *(const PG8_LAS bf16x8*)(lds + PG8_SA(b, h) + aoff + m * 2048 + k * 1024); } while (0)
#define PG8_LDB(dst, b, h) do { _Pragma("unroll") for (int n = 0; n < 2; ++n) _Pragma("unroll") for (int k = 0; k < 2; ++k) dst[n][k] = *(const PG8_LAS bf16x8*)(lds + PG8_SB(b, h) + boff + n * 2048 + k * 1024); } while (0)
#define PG8_MMA(ai, bj, At, Bt) do { __builtin_amdgcn_s_setprio(1); _Pragma("unroll") for (int m = 0; m < 4; ++m) _Pragma("unroll") for (int n = 0; n < 2; ++n) _Pragma("unroll") for (int k = 0; k < 2; ++k) \
        acc[ai][bj][m][n] = __builtin_amdgcn_mfma_f32_16x16x32_bf16(Bt[n][k], At[m][k], acc[ai][bj][m][n], 0, 0, 0); __builtin_amdgcn_s_setprio(0); } while (0)
#define PG8_WAIT_V(n) asm volatile("s_waitcnt vmcnt(" #n ")" ::: "memory")
#define PG8_WAIT_L(n) asm volatile("s_waitcnt lgkmcnt(" #n ")" ::: "memory")
#define PG8_BAR __builtin_amdgcn_s_barrier()
#define PG8_SCHED __builtin_amdgcn_sched_barrier(0)
    Unit cur, nxt; int ui = 0;
    if (!S.next(0, cur)) return;
    f32x4 acc[2][2][4][2];
#pragma unroll
    for (int a = 0; a < 2; ++a)
#pragma unroll
        for (int b = 0; b < 2; ++b)
#pragma unroll
            for (int m = 0; m < 4; ++m)
#pragma unroll
                for (int n = 0; n < 2; ++n) acc[a][b][m][n] = (f32x4){0.f, 0.f, 0.f, 0.f};
    bf16x8 At[4][2], B0[2][2], B1[2][2];
    const char* cA = (const char*)g.A + (size_t)cur.pm * tstep; const char* cB = (const char*)g.Bt + (size_t)cur.pn * tstep;
    S.a_ready(cur);
    PG8_STAGE(PG8_SB(0, 0), cB, voffB); PG8_STAGE(PG8_SA(0, 0), cA, voffA); PG8_STAGE(PG8_SB(0, 1), cB + hstep, voffB); PG8_STAGE(PG8_SA(0, 1), cA + hstep, voffA);
    if (wr == 1) PG8_BAR;
    PG8_WAIT_V(4); PG8_BAR;
    PG8_STAGE(PG8_SB(1, 0), cB + kstep, voffB); PG8_STAGE(PG8_SA(1, 0), cA + kstep, voffA); PG8_STAGE(PG8_SB(1, 1), cB + hstep + kstep, voffB);
    PG8_WAIT_V(6); PG8_BAR;
    PG8_STAMP();
    for (;;) {
        const bool has_next = S.next(ui + 1, nxt);
        const char* nA = has_next ? (const char*)g.A + (size_t)nxt.pm * tstep : cA; const char* nB = has_next ? (const char*)g.Bt + (size_t)nxt.pn * tstep : cB;
        for (int t = 0; t < nt; t += 2) {
            const bool last = (t == nt - 2);
            const char* a1 = cA + (size_t)(t + 1) * kstep;
            const char* a2 = last ? nA : cA + (size_t)(t + 2) * kstep; const char* b2 = last ? nB : cB + (size_t)(t + 2) * kstep;
            const char* a3 = a2 + kstep; const char* b3 = b2 + kstep;
            if (last && has_next) S.a_ready(nxt);
            PG8_LDB(B0, 0, 0); PG8_SCHED; PG8_LDA(At, 0, 0); PG8_STAGE(PG8_SA(1, 1), a1 + hstep, voffA);
            PG8_WAIT_L(8); PG8_BAR; PG8_WAIT_L(0); PG8_MMA(0, 0, At, B0); PG8_BAR; PG8_SCHED;
            PG8_LDB(B1, 0, 1); PG8_STAGE(PG8_SB(0, 0), b2, voffB);
            PG8_BAR; PG8_WAIT_L(0); PG8_MMA(0, 1, At, B1); PG8_BAR;
            PG8_LDA(At, 0, 1); PG8_STAGE(PG8_SA(0, 0), a2, voffA);
            PG8_BAR; PG8_WAIT_L(0); PG8_MMA(1, 0, At, B0); PG8_BAR; PG8_SCHED;
            PG8_STAGE(PG8_SB(0, 1), b2 + hstep, voffB);
            PG8_WAIT_V(6); PG8_BAR; PG8_MMA(1, 1, At, B1); PG8_BAR;
            PG8_LDB(B0, 1, 0); PG8_SCHED; PG8_LDA(At, 1, 0); PG8_STAGE(PG8_SA(0, 1), a2 + hstep, voffA);
            PG8_WAIT_L(8); PG8_BAR; PG8_WAIT_L(0); PG8_MMA(0, 0, At, B0); PG8_BAR; PG8_SCHED;
            PG8_LDB(B1, 1, 1); PG8_STAGE(PG8_SB(1, 0), b3, voffB);
            PG8_BAR; PG8_WAIT_L(0); PG8_MMA(0, 1, At, B1); PG8_BAR;
            PG8_LDA(At, 1, 1); PG8_STAGE(PG8_SA(1, 0), a3, voffA);
            PG8_BAR; PG8_WAIT_L(0); PG8_MMA(1, 0, At, B0); PG8_BAR; PG8_SCHED;
            PG8_STAGE(PG8_SB(1, 1), b3 + hstep, voffB);
            PG8_WAIT_V(6); PG8_BAR; PG8_MMA(1, 1, At, B1); PG8_BAR;
        }
        PG8_STAMP();
        if constexpr (!Epi::AFTER_DRAIN) { E(acc, cur, wr, wc, fr, fq); S.done(cur); }
        PG8_STAMP();
        if (!has_next) break;
#pragma unroll
        for (int a = 0; a < 2; ++a)
#pragma unroll
            for (int b = 0; b < 2; ++b)
#pragma unroll
                for (int m = 0; m < 4; ++m)
#pragma unroll
                    for (int n = 0; n < 2; ++n) acc[a][b][m][n] = (f32x4){0.f, 0.f, 0.f, 0.f};
        cur = nxt; cA = nA; cB = nB; ++ui;
    }
    PG8_WAIT_V(0);
    if (wr == 0) PG8_BAR;
    PG8_BAR;
    if constexpr (Epi::AFTER_DRAIN) { E.fused(acc, cur, wr, wc, fr, fq, lds, wid, lane); S.done(cur); }
    PG8_STAMP();
    if (STAMP && wid == 0) { stamps[lane] = lane < nts ? (((unsigned long long)(unsigned)ts_hi << 32) | (unsigned)ts_lo) : 0ull;
        if (lane == 62) stamps[62] = rt_entry; if (lane == 63) stamps[63] = (unsigned long long)wall_clock64(); }
#undef PG8_STAMP
#undef PG8_SA
#undef PG8_SB
#undef PG8_STAGE
#undef PG8_LDA
#undef PG8_LDB
#undef PG8_MMA
#undef PG8_WAIT_V
#undef PG8_WAIT_L
#undef PG8_BAR
#undef PG8_SCHED
}
}

typedef pg8::bf16_t bf16_t;
typedef pg8::bf16x8 bf16x8;
typedef pg8::f32x4 f32x4;
typedef unsigned short u16;
typedef unsigned u32x2 __attribute__((ext_vector_type(2)));
typedef unsigned u32x4 __attribute__((ext_vector_type(4)));
typedef float f32x2 __attribute__((ext_vector_type(2)));
#define LAS __attribute__((address_space(3)))

constexpr int D = 1024, NLAT = 32768, NCTX = 2048, MTOK = 34816, SEQ = 4096, CTXL = 256, FH = 2816, NMOD = 9;
constexpr int LDS_BYTES = 131072;
constexpr size_t OFF_MOD = 4096, OFF_LB = 1331200, OFF_ROPE = 1347584, OFF_W = 2097152, OFF_H = 50331648, OFF_A = 192937984, OFF_BIG = 264241152;
constexpr size_t T16 = 71303168;
constexpr size_t WS_END = OFF_BIG + 5 * T16;
constexpr size_t W_GU0 = 0, W_D0 = 5767168, W_GU1 = 8650752, W_D1 = 14417920, W_MIX = 17301504;
constexpr size_t W_IN = W_MIX, W_OUT = W_MIX + 5242880;
constexpr size_t W_DN = W_MIX, W_UQ = W_MIX + 786432, W_K = W_MIX + 1376256, W_V = W_MIX + 1638400, W_O = W_MIX + 1900544;
constexpr float QSCALE = 0.07216878364870322f * 1.4426950408889634f;

struct Params {
    const float *x, *c, *ctx, *c_ctx, *mod_w, *mod_b, *norm_g, *w_gate, *w_up, *w_down, *hg_w_in, *hg_w_out, *hg_gn, *hg_lb, *mla_w_down, *mla_q_norm, *mla_w_uq, *mla_kv_norm, *mla_w_ukv, *mla_w_o, *final_g;
    float* out; unsigned char* ws;
};

__device__ __forceinline__ int fresh_tid() { int t = threadIdx.x; asm volatile("" : "+v"(t)); return t; }
__device__ __forceinline__ unsigned pk_bf16(float lo, float hi) { unsigned r; asm volatile("v_cvt_pk_bf16_f32 %0, %1, %2" : "=v"(r) : "v"(lo), "v"(hi)); return r; }
__device__ __forceinline__ float bf_lo(unsigned w) { return __uint_as_float(w << 16); }
__device__ __forceinline__ float bf_hi(unsigned w) { return __uint_as_float(w & 0xffff0000u); }
__device__ __forceinline__ float sigmoidf_(float x) { return __builtin_amdgcn_rcpf(1.0f + __expf(-x)); }
__device__ __forceinline__ float siluf_(float x) { return x * sigmoidf_(x); }
__device__ __forceinline__ float wave_sum(float v) {
#pragma unroll
    for (int o = 1; o < 64; o <<= 1) v += __shfl_xor(v, o);
    return v;
}
__device__ __forceinline__ const float* in_row(const Params& p, int row) { return row < NLAT ? p.x + (size_t)row * D : p.ctx + (size_t)(row - NLAT) * D; }
__device__ __forceinline__ int mod_row(int row) { return row < NLAT ? (row >> 12) : 8; }

#define EPI_ARGS const f32x4 (&acc)[2][2][4][2], const pg8::Unit& u, int wr, int wc, int fr, int fq
struct EpiGateUp {
    static constexpr bool PERM = false, AFTER_DRAIN = false; bf16_t* hid;
    __device__ __forceinline__ void operator()(EPI_ARGS) const {
        const int row0 = u.pm * 256 + wr * 64 + fr, hc0 = u.pn * 128 + wc * 16 + 4 * fq;
#pragma unroll
        for (int ai = 0; ai < 2; ++ai)
#pragma unroll
            for (int m = 0; m < 4; ++m) { bf16_t* rp = hid + (size_t)(row0 + ai * 128 + m * 16) * FH + hc0;
#pragma unroll
                for (int bj = 0; bj < 2; ++bj) { const f32x4 g = acc[ai][bj][m][0], up = acc[ai][bj][m][1];
                    u32x2 w; w.x = pk_bf16(siluf_(g[0]) * up[0], siluf_(g[1]) * up[1]); w.y = pk_bf16(siluf_(g[2]) * up[2], siluf_(g[3]) * up[3]);
                    *(u32x2*)(rp + bj * 64) = w; } }
    }
};
struct EpiResid {
    static constexpr bool PERM = false, AFTER_DRAIN = false; const float* x; const float* ctx; float* H; const float* modl; int midx; float coef; int from_input;
    __device__ __forceinline__ void operator()(EPI_ARGS) const {
        const int row0 = u.pm * 256 + wr * 64 + fr, col0 = u.pn * 256 + wc * 32 + 4 * fq;
        const float* mv = modl + (size_t)mod_row(u.pm * 256) * (NMOD * D) + midx * D + col0;
        f32x4 mm[2][2];
#pragma unroll
        for (int bj = 0; bj < 2; ++bj)
#pragma unroll
            for (int n = 0; n < 2; ++n) mm[bj][n] = *(const f32x4*)(mv + bj * 128 + n * 16) * coef;
#pragma unroll
        for (int ai = 0; ai < 2; ++ai)
#pragma unroll
            for (int m = 0; m < 4; ++m) { const int row = row0 + ai * 128 + m * 16;
                const float* sp = (from_input ? (row < NLAT ? x + (size_t)row * D : ctx + (size_t)(row - NLAT) * D) : H + (size_t)row * D) + col0; float* dp = H + (size_t)row * D + col0;
#pragma unroll
                for (int bj = 0; bj < 2; ++bj)
#pragma unroll
                    for (int n = 0; n < 2; ++n) { const f32x4 s = *(const f32x4*)(sp + bj * 128 + n * 16); *(f32x4*)(dp + bj * 128 + n * 16) = s + mm[bj][n] * acc[ai][bj][m][n]; }
                asm volatile("" ::: "memory"); }
    }
};
struct EpiHgIn {
    static constexpr bool PERM = false, AFTER_DRAIN = false; u16* base; const float* lb;
    __device__ __forceinline__ void operator()(EPI_ARGS) const {
        const int kind = u.pn >> 2; const int row0 = u.pm * 256 + wr * 64 + fr, col0 = (u.pn & 3) * 256 + wc * 32 + 4 * fq;
        u16* dst = base + (size_t)kind * (T16 / 2);
#pragma unroll
        for (int ai = 0; ai < 2; ++ai)
#pragma unroll
            for (int m = 0; m < 4; ++m) { u16* rp = dst + (size_t)(row0 + ai * 128 + m * 16) * D + col0;
#pragma unroll
                for (int bj = 0; bj < 2; ++bj)
#pragma unroll
                    for (int n = 0; n < 2; ++n) { const f32x4 v = acc[ai][bj][m][n]; u32x2 w;
                        if (kind == 1 || kind == 2) { const f32x4 l4 = *(const f32x4*)(lb + (kind - 1) * D + col0 + bj * 128 + n * 16); unsigned q[4];
#pragma unroll
                            for (int e = 0; e < 4; ++e) { const float f = l4[e] + (1.0f - l4[e]) * sigmoidf_(v[e]); q[e] = (unsigned)__builtin_rintf(fminf(fmaxf(f, 0.f), 1.f) * 65535.0f); }
                            w.x = q[0] | (q[1] << 16); w.y = q[2] | (q[3] << 16); }
                        else if (kind == 4) { w.x = pk_bf16(siluf_(v[0]), siluf_(v[1])); w.y = pk_bf16(siluf_(v[2]), siluf_(v[3])); }
                        else { w.x = pk_bf16(v[0], v[1]); w.y = pk_bf16(v[2], v[3]); }
                        *(u32x2*)(rp + bj * 128 + n * 16) = w; } }
    }
};
struct EpiMlaDown {
    static constexpr bool PERM = false, AFTER_DRAIN = false; float* dproj; bf16_t* kr; const float* rope;
    __device__ __forceinline__ void operator()(EPI_ARGS) const {
        const int row0 = u.pm * 256 + wr * 64 + fr;
#pragma unroll
        for (int bj = 0; bj < 2; ++bj) { const int gcol = u.pn * 256 + bj * 128 + wc * 32;
            if (gcol < 640) {
#pragma unroll
                for (int ai = 0; ai < 2; ++ai)
#pragma unroll
                    for (int m = 0; m < 4; ++m) { float* rp = dproj + (size_t)(row0 + ai * 128 + m * 16) * 640 + gcol + 4 * fq;
                        *(f32x4*)rp = acc[ai][bj][m][0]; *(f32x4*)(rp + 16) = acc[ai][bj][m][1]; }
            } else if (gcol < 704) { const int axis = (gcol - 640) >> 5;
#pragma unroll
                for (int ai = 0; ai < 2; ++ai)
#pragma unroll
                    for (int m = 0; m < 4; ++m) { const int row = row0 + ai * 128 + m * 16; f32x4 a = acc[ai][bj][m][0], b = acc[ai][bj][m][1];
                        if (row < NLAT) { const int pos = row & 4095, P = axis ? (pos & 63) : (pos >> 6); const float* cs = rope + (P * 16 + 4 * fq) * 2;
                            const f32x4 c0 = *(const f32x4*)cs, c1 = *(const f32x4*)(cs + 4);
                            const f32x4 cv = {c0[0], c0[2], c1[0], c1[2]}, sv = {c0[1], c0[3], c1[1], c1[3]};
                            const f32x4 na = a * cv - b * sv, nb = a * sv + b * cv; a = na; b = nb; }
                        bf16_t* rp = kr + (size_t)row * 64 + axis * 32 + 4 * fq; u32x2 w;
                        w.x = pk_bf16(a[0], a[1]); w.y = pk_bf16(a[2], a[3]); *(u32x2*)rp = w;
                        w.x = pk_bf16(b[0], b[1]); w.y = pk_bf16(b[2], b[3]); *(u32x2*)(rp + 16) = w; asm volatile("" ::: "memory"); }
            }
        }
    }
};
struct EpiBf16 {
    static constexpr bool PERM = false, AFTER_DRAIN = false; bf16_t* o; size_t ldc; float scale;
    __device__ __forceinline__ void operator()(EPI_ARGS) const {
        const int row0 = u.pm * 256 + wr * 64 + fr, col0 = u.pn * 256 + wc * 32 + 4 * fq;
#pragma unroll
        for (int ai = 0; ai < 2; ++ai)
#pragma unroll
            for (int m = 0; m < 4; ++m) { bf16_t* rp = o + (size_t)(row0 + ai * 128 + m * 16) * ldc + col0;
#pragma unroll
                for (int bj = 0; bj < 2; ++bj)
#pragma unroll
                    for (int n = 0; n < 2; ++n) { const f32x4 v = acc[ai][bj][m][n] * scale; u32x2 w; w.x = pk_bf16(v[0], v[1]); w.y = pk_bf16(v[2], v[3]); *(u32x2*)(rp + bj * 128 + n * 16) = w; } }
    }
};
template <class Epi> __device__ __forceinline__ void run_gemm(LAS unsigned char* lds, const bf16_t* A, const bf16_t* Bt, int M, int N, int K, const Epi& E) {
    pg8::Gemm g; g.A = A; g.Bt = Bt; g.M = M; g.N = N; g.K = K;
    pg8::StaticOrder S; S.init(M, N, gridDim.x, blockIdx.x);
    pg8::gemm_phase<Epi, pg8::StaticOrder, false>(lds, g, S, E, nullptr);
}

__device__ __forceinline__ const float* conv_src(int kind, const float* s0, const float* s1, int R) {
    switch (kind) {
        case 1: return ((R >> 4) & 1 ? s1 : s0) + (R >> 5) * 16 + (R & 15);
        case 2: return s0 + (R >> 7) * 256 + (R & 127);
        case 3: return s0 + (R >> 7) * 256 + 128 + (R & 127);
        case 4: return R < 704 ? s0 + R : nullptr;
        default: return s0 + R;
    }
}
__device__ __forceinline__ void conv_T(unsigned char* smem, int kind, const float* s0, const float* s1, int ldn, int Ndst, int K, bf16_t* dst, int rot) {
    float* tile = (float*)smem;
    const int tid = fresh_tid(), nkb = K / 64, ntiles = (Ndst / 64) * nkb, G = gridDim.x;
    for (int t = (blockIdx.x + rot) % G; t < ntiles; t += G) {
        const int R0 = (t / nkb) * 64, k0 = (t % nkb) * 64;
        { const int Rl = tid & 63, kr = tid >> 6; const float* sp = conv_src(kind, s0, s1, R0 + Rl);
#pragma unroll
            for (int ps = 0; ps < 8; ++ps) { const int kl = ps * 8 + kr; tile[Rl * 65 + kl] = sp ? sp[(size_t)(k0 + kl) * ldn] : 0.f; } }
        __syncthreads();
        { const int Rl = tid >> 3, c = tid & 7; const float* s = tile + Rl * 65 + 8 * c; u32x4 w;
            w.x = pk_bf16(s[0], s[1]); w.y = pk_bf16(s[2], s[3]); w.z = pk_bf16(s[4], s[5]); w.w = pk_bf16(s[6], s[7]);
            *(u32x4*)(dst + (size_t)(R0 + Rl) * K + k0 + 8 * c) = w; }
        __syncthreads();
    }
}
__device__ __forceinline__ void convert_layer(const Params& p, unsigned char* smem, int layer) {
    bf16_t* W = (bf16_t*)(p.ws + OFF_W);
    for (int s = 0; s < 2; ++s) {
        const size_t o = ((size_t)layer * 2 + s) * D * FH;
        conv_T(smem, 1, p.w_gate + o, p.w_up + o, FH, 2 * FH, D, W + (s ? W_GU1 : W_GU0), s * 64);
        conv_T(smem, 0, p.w_down + o, nullptr, D, D, FH, W + (s ? W_D1 : W_D0), s * 64 + 32);
    }
    const int j = layer >> 1;
    if ((layer & 1) == 0) {
        conv_T(smem, 0, p.hg_w_in + (size_t)j * D * 5120, nullptr, 5120, 5120, D, W + W_IN, 128);
        conv_T(smem, 0, p.hg_w_out + (size_t)j * D * D, nullptr, D, D, D, W + W_OUT, 160);
    } else {
        conv_T(smem, 4, p.mla_w_down + (size_t)j * D * 704, nullptr, 704, 768, D, W + W_DN, 128);
        conv_T(smem, 0, p.mla_w_uq + (size_t)j * 384 * 1536, nullptr, 1536, 1536, 384, W + W_UQ, 176);
        conv_T(smem, 2, p.mla_w_ukv + (size_t)j * 256 * 2048, nullptr, 2048, 1024, 256, W + W_K, 200);
        conv_T(smem, 3, p.mla_w_ukv + (size_t)j * 256 * 2048, nullptr, 2048, 1024, 256, W + W_V, 216);
        conv_T(smem, 0, p.mla_w_o + (size_t)j * D * D, nullptr, D, D, D, W + W_O, 232);
    }
}
__device__ __forceinline__ void phase_prologue(const Params& p, unsigned char* smem) {
    float* sS = (float*)smem;
    float* sP = sS + 9 * 1024;
    const int tid = fresh_tid(), wave = tid >> 6, lane = tid & 63;
    for (int i = tid; i < 9 * 1024; i += 512) { const float v = i < 8192 ? p.c[i] : p.c_ctx[i - 8192]; sS[i] = siluf_(v); }
    __syncthreads();
    float* mod = (float*)(p.ws + OFF_MOD);
    for (int item = blockIdx.x; item < 4 * 144; item += gridDim.x) {
        const int l = item / 144, j0 = (item % 144) * 64; const float* wp = p.mod_w + (size_t)l * D * (NMOD * D) + j0 + lane;
        float a[9];
#pragma unroll
        for (int r = 0; r < 9; ++r) a[r] = 0.f;
#pragma unroll 8
        for (int kk = 0; kk < 128; ++kk) { const int k = wave * 128 + kk; const float w = wp[(size_t)k * (NMOD * D)];
#pragma unroll
            for (int r = 0; r < 9; ++r) a[r] += sS[r * 1024 + k] * w; }
#pragma unroll
        for (int r = 0; r < 9; ++r) sP[(wave * 9 + r) * 64 + lane] = a[r];
        __syncthreads();
        for (int i = tid; i < 9 * 64; i += 512) { const int r = i >> 6, jl = i & 63; float s = p.mod_b[(size_t)l * (NMOD * D) + j0 + jl];
#pragma unroll
            for (int w = 0; w < 8; ++w) s += sP[(w * 9 + r) * 64 + jl];
            mod[((size_t)l * 9 + r) * (NMOD * D) + j0 + jl] = s; }
        __syncthreads();
    }
    const int gt = blockIdx.x * 512 + tid;
    if (gt < 4096) { float* lb = (float*)(p.ws + OFF_LB); const int idx = gt & 2047;
        if (gt < 2048) lb[gt] = 0.f; else lb[gt] = sigmoidf_(p.hg_lb[2048 + idx] - p.hg_lb[idx]); }
    if (gt >= 4096 && gt < 4096 + 1024) { float* rt = (float*)(p.ws + OFF_ROPE); const int i = gt - 4096, P = i >> 4, j = i & 15;
        const float inv = exp2f(-(float)j * (13.287712379549449f / 16.0f)); const float xa = (float)P * inv;
        const float kq = __builtin_rintf(xa * 0.15915494309189535f); float r = fmaf(-kq, 6.28125f, xa); r = fmaf(-kq, 1.9353071795864769e-3f, r);
        rt[2 * i] = cosf(r); rt[2 * i + 1] = sinf(r); }
}
__device__ __forceinline__ void phase_norm(const Params& p, int layer, int gi, int mbase, int from_input) {
    const int tid = fresh_tid(); const int lane = tid & 63, gw = blockIdx.x * 8 + (tid >> 6), nw = gridDim.x * 8;
    const float* H = (const float*)(p.ws + OFF_H); bf16_t* A = (bf16_t*)(p.ws + OFF_A);
    const float* modl = (const float*)(p.ws + OFF_MOD) + (size_t)layer * 9 * (NMOD * D); const float* g = p.norm_g + ((size_t)layer * 3 + gi) * D;
    for (int row = gw; row < MTOK; row += nw) {
        const float* hp = from_input ? in_row(p, row) : H + (size_t)row * D; const float* mr = modl + (size_t)mod_row(row) * (NMOD * D) + mbase * D;
        f32x4 v[4]; float s = 0.f;
#pragma unroll
        for (int j = 0; j < 4; ++j) { v[j] = *(const f32x4*)(hp + 4 * lane + 256 * j); s += (v[j][0] * v[j][0] + v[j][1] * v[j][1]) + (v[j][2] * v[j][2] + v[j][3] * v[j][3]); }
        const float rstd = __builtin_amdgcn_rsqf(wave_sum(s) * (1.0f / D) + 1e-6f);
#pragma unroll
        for (int j = 0; j < 4; ++j) { const int c = 4 * lane + 256 * j; const f32x4 gg = *(const f32x4*)(g + c), sh = *(const f32x4*)(mr + c), sc = *(const f32x4*)(mr + D + c);
            const f32x4 y = (v[j] * rstd * gg) * (sc + 1.0f) + sh; u32x2 w; w.x = pk_bf16(y[0], y[1]); w.y = pk_bf16(y[2], y[3]); *(u32x2*)(A + (size_t)row * D + c) = w; }
    }
}
__device__ __forceinline__ void phase_final(const Params& p) {
    const int tid = fresh_tid(); const int lane = tid & 63, gw = blockIdx.x * 8 + (tid >> 6), nw = gridDim.x * 8; const float* H = (const float*)(p.ws + OFF_H);
    for (int row = gw; row < NLAT; row += nw) { const float* hp = H + (size_t)row * D; f32x4 v[4]; float s = 0.f;
#pragma unroll
        for (int j = 0; j < 4; ++j) { v[j] = *(const f32x4*)(hp + 4 * lane + 256 * j); s += (v[j][0] * v[j][0] + v[j][1] * v[j][1]) + (v[j][2] * v[j][2] + v[j][3] * v[j][3]); }
        const float rstd = __builtin_amdgcn_rsqf(wave_sum(s) * (1.0f / D) + 1e-6f);
#pragma unroll
        for (int j = 0; j < 4; ++j) { const int c = 4 * lane + 256 * j; *(f32x4*)(p.out + (size_t)row * D + c) = v[j] * rstd * *(const f32x4*)(p.final_g + c); } }
}
__device__ __forceinline__ void phase_readout(const Params& p, int j) {
    const int tid = fresh_tid(); const int lane = tid & 63, gw = blockIdx.x * 8 + (tid >> 6), nw = gridDim.x * 8;
    const bf16_t* O = (const bf16_t*)(p.ws + OFF_A); const bf16_t* SG = (const bf16_t*)(p.ws + OFF_BIG + 4 * T16); bf16_t* R = (bf16_t*)(p.ws + OFF_BIG);
    const float* gn = p.hg_gn + (size_t)j * 128 + (lane & 7) * 16;
    for (int row = gw; row < MTOK; row += nw) { const size_t off = (size_t)row * D + 16 * lane;
        const u32x4 o0 = *(const u32x4*)(O + off), o1 = *(const u32x4*)(O + off + 8), g0 = *(const u32x4*)(SG + off), g1 = *(const u32x4*)(SG + off + 8);
        float ov[16], gv[16];
#pragma unroll
        for (int e = 0; e < 4; ++e) { ov[2 * e] = bf_lo(o0[e]); ov[2 * e + 1] = bf_hi(o0[e]); ov[8 + 2 * e] = bf_lo(o1[e]); ov[9 + 2 * e] = bf_hi(o1[e]);
            gv[2 * e] = bf_lo(g0[e]); gv[2 * e + 1] = bf_hi(g0[e]); gv[8 + 2 * e] = bf_lo(g1[e]); gv[9 + 2 * e] = bf_hi(g1[e]); }
        float s = 0.f;
#pragma unroll
        for (int e = 0; e < 16; ++e) s += ov[e] * ov[e];
        s += __shfl_xor(s, 1); s += __shfl_xor(s, 2); s += __shfl_xor(s, 4);
        const float rstd = __builtin_amdgcn_rsqf(s * (1.0f / 128.0f) + 1e-6f); u32x4 w0, w1;
#pragma unroll
        for (int e = 0; e < 4; ++e) { w0[e] = pk_bf16(ov[2 * e] * rstd * gn[2 * e] * gv[2 * e], ov[2 * e + 1] * rstd * gn[2 * e + 1] * gv[2 * e + 1]);
            w1[e] = pk_bf16(ov[8 + 2 * e] * rstd * gn[8 + 2 * e] * gv[8 + 2 * e], ov[9 + 2 * e] * rstd * gn[9 + 2 * e] * gv[9 + 2 * e]); }
        *(u32x4*)(R + off) = w0; *(u32x4*)(R + off + 8) = w1; }
}
__device__ __forceinline__ void phase_mla_norm(const Params& p, int j) {
    const int tid = fresh_tid(); const int lane = tid & 63, gw = blockIdx.x * 8 + (tid >> 6), nw = gridDim.x * 8;
    const float* DP = (const float*)(p.ws + OFF_BIG); bf16_t* CQN = (bf16_t*)(p.ws + OFF_BIG + 106954752 + 2 * T16); bf16_t* CKVN = CQN + (size_t)MTOK * 384;
    const float* qn = p.mla_q_norm + (size_t)j * 384; const float* kn = p.mla_kv_norm + (size_t)j * 256;
    for (int row = gw; row < MTOK; row += nw) { const float* dp = DP + (size_t)row * 640;
        f32x2 a[3]; float s = 0.f;
#pragma unroll
        for (int t = 0; t < 3; ++t) { a[t] = *(const f32x2*)(dp + 2 * lane + 128 * t); s += a[t][0] * a[t][0] + a[t][1] * a[t][1]; }
        const f32x4 b = *(const f32x4*)(dp + 384 + 4 * lane); const float s2 = (b[0] * b[0] + b[1] * b[1]) + (b[2] * b[2] + b[3] * b[3]);
        const float r1 = __builtin_amdgcn_rsqf(wave_sum(s) * (1.0f / 384.0f) + 1e-6f), r2 = __builtin_amdgcn_rsqf(wave_sum(s2) * (1.0f / 256.0f) + 1e-6f);
#pragma unroll
        for (int t = 0; t < 3; ++t) { const int c = 2 * lane + 128 * t; *(unsigned*)(CQN + (size_t)row * 384 + c) = pk_bf16(a[t][0] * r1 * qn[c], a[t][1] * r1 * qn[c + 1]); }
        { const int c = 4 * lane; u32x2 w; w.x = pk_bf16(b[0] * r2 * kn[c], b[1] * r2 * kn[c + 1]); w.y = pk_bf16(b[2] * r2 * kn[c + 2], b[3] * r2 * kn[c + 3]); *(u32x2*)(CKVN + (size_t)row * 256 + c) = w; } }
}

__device__ __forceinline__ float dpp_xor1(float v) { return __int_as_float(__builtin_amdgcn_update_dpp(0, __float_as_int(v), 0xB1, 0xF, 0xF, true)); }
__device__ __forceinline__ float dpp_xor2(float v) { return __int_as_float(__builtin_amdgcn_update_dpp(0, __float_as_int(v), 0x4E, 0xF, 0xF, true)); }
__device__ __forceinline__ int scan_block(int dir, int i) { return dir == 0 ? i : (i < 8 ? 7 - i : 143 - i); }
__device__ __forceinline__ int scan_row(int b, int X, int tt) { return X < 8 ? NLAT + b * CTXL + X * 32 + tt : b * SEQ + (X - 8) * 32 + tt; }
__device__ __forceinline__ void phase_scan(const Params& p, unsigned char* smem) {
    float* sF = (float*)smem;
    float* sQ = sF + 2 * 32 * 128;
    float* sV = sQ + 2 * 32 * 128;
    float* sPO = sV + 2 * 32 * 32;
    const u16* QH = (const u16*)(p.ws + OFF_BIG); const u16* FF = QH + T16 / 2; const u16* FB = FF + T16 / 2; const u16* VI = FB + T16 / 2; bf16_t* O = (bf16_t*)(p.ws + OFF_A);
    const int tid = fresh_tid(), wave = tid >> 6, lane = tid & 63, dir = wave >> 2, ks = wave & 3, vg = lane >> 2, ksub = lane & 3, kbase = 32 * ks + 8 * ksub;
    for (int task = blockIdx.x; task < 256; task += gridDim.x) {
        const int b = task >> 5, h = (task >> 2) & 7, vq = task & 3;
        float S[16];
#pragma unroll
        for (int e = 0; e < 16; ++e) S[e] = 0.f;
        u32x4 rf[2], rq[2], rv;
        const int stt = tid >> 4, sc = tid & 15;
        const int vdir = (tid >> 7) & 1, vtt = (tid & 127) >> 2, vc = tid & 3;
#define SCAN_LOAD(it) do { _Pragma("unroll") for (int d = 0; d < 2; ++d) { const size_t ro = (size_t)scan_row(b, scan_block(d, (it)), stt) * D + h * 128 + 8 * sc; \
            rf[d] = *(const u32x4*)((d ? FB : FF) + ro); rq[d] = *(const u32x4*)(QH + ro); } \
            if (tid < 256) rv = *(const u32x4*)(VI + (size_t)scan_row(b, scan_block(vdir, (it)), vtt) * D + h * 128 + vq * 32 + 8 * vc); } while (0)
#define SCAN_STORE() do { _Pragma("unroll") for (int d = 0; d < 2; ++d) { float* fp = sF + (d * 32 + stt) * 128 + 8 * sc; float* qp = sQ + (d * 32 + stt) * 128 + 8 * sc; \
            _Pragma("unroll") for (int e = 0; e < 4; ++e) { fp[2 * e] = (float)(rf[d][e] & 0xffffu) * (1.0f / 65535.0f); fp[2 * e + 1] = (float)(rf[d][e] >> 16) * (1.0f / 65535.0f); \
                qp[2 * e] = bf_lo(rq[d][e]); qp[2 * e + 1] = bf_hi(rq[d][e]); } } \
            if (tid < 256) { float* vp = sV + (vdir * 32 + vtt) * 32 + 8 * vc; _Pragma("unroll") for (int e = 0; e < 4; ++e) { vp[2 * e] = bf_lo(rv[e]); vp[2 * e + 1] = bf_hi(rv[e]); } } } while (0)
        SCAN_LOAD(0); SCAN_STORE(); __syncthreads();
        for (int it = 0; it < 136; ++it) {
            if (it + 1 < 136) SCAN_LOAD(it + 1);
            for (int s = 0; s < 32; ++s) { const int tt = dir ? 31 - s : s;
                const float* fp = sF + (dir * 32 + tt) * 128 + kbase; const float* qp = sQ + (dir * 32 + tt) * 128 + kbase;
                const f32x4 f0 = *(const f32x4*)fp, f1 = *(const f32x4*)(fp + 4), q0 = *(const f32x4*)qp, q1 = *(const f32x4*)(qp + 4);
                const f32x2 vv = *(const f32x2*)(sV + (dir * 32 + tt) * 32 + 2 * vg);
                float o0 = 0.f, o1 = 0.f;
#pragma unroll
                for (int k = 0; k < 8; ++k) { const float f = k < 4 ? f0[k & 3] : f1[k & 3], q = k < 4 ? q0[k & 3] : q1[k & 3];
                    S[2 * k] = fmaf(f, S[2 * k] - vv[0], vv[0]); S[2 * k + 1] = fmaf(f, S[2 * k + 1] - vv[1], vv[1]);
                    o0 = fmaf(S[2 * k], q, o0); o1 = fmaf(S[2 * k + 1], q, o1); }
                o0 += dpp_xor1(o0); o1 += dpp_xor1(o1); o0 += dpp_xor2(o0); o1 += dpp_xor2(o1);
                if (ksub == 0) { f32x2 w = {o0, o1}; *(f32x2*)(sPO + ((dir * 32 + tt) * 4 + ks) * 32 + 2 * vg) = w; }
            }
            __syncthreads();
            if (tid < 256) { const int tt = tid >> 3, v4 = tid & 7;
#pragma unroll
                for (int d = 0; d < 2; ++d) { const float* pp = sPO + (d * 32 + tt) * 128 + 4 * v4;
                    f32x4 o = *(const f32x4*)pp + *(const f32x4*)(pp + 32) + *(const f32x4*)(pp + 64) + *(const f32x4*)(pp + 96);
                    const int X = scan_block(d, it); const int other = d == 0 ? (X < 8 ? 7 - X : 143 - X) : X;
                    bf16_t* op = O + (size_t)scan_row(b, X, tt) * D + h * 128 + vq * 32 + 4 * v4;
                    if (it > other) { const u32x2 pv = *(const u32x2*)op; o[0] += bf_lo(pv.x); o[1] += bf_hi(pv.x); o[2] += bf_lo(pv.y); o[3] += bf_hi(pv.y); }
                    u32x2 w; w.x = pk_bf16(o[0], o[1]); w.y = pk_bf16(o[2], o[3]); *(u32x2*)op = w; } }
            if (it + 1 < 136) SCAN_STORE();
            __syncthreads();
        }
#undef SCAN_LOAD
#undef SCAN_STORE
    }
}

constexpr int KNROW = 272, KRROW = 144, VROW = 144, KNBUF = 64 * KNROW, KRBUF = 64 * KRROW, VBUF = 128 * VROW, ATT_STAGE = KNBUF + KRBUF + VBUF;
__device__ __forceinline__ void phase_attn(const Params& p, unsigned char* smem, bool with_ctx) {
    const bf16_t* QB = (const bf16_t*)(p.ws + OFF_BIG); const bf16_t* KN = QB + (size_t)MTOK * 1536; const bf16_t* VT = KN + (size_t)MTOK * D;
    const bf16_t* KR = VT + (size_t)MTOK * D + (size_t)MTOK * 384 + (size_t)MTOK * 256; bf16_t* AO = (bf16_t*)(p.ws + OFF_A);
    LAS unsigned char* lds = (LAS unsigned char*)smem;
    const int tid = fresh_tid(), wave = __builtin_amdgcn_readfirstlane(tid >> 6), lane = tid & 63, fr = lane & 15, fq = lane >> 4;
    const int nrounds = with_ctx ? 5 : 4; const int xcd = blockIdx.x & 7, jx = blockIdx.x >> 3;
    for (int rnd = 0; rnd < nrounds; ++rnd) {
        int b, head, qrow0, t0;
        if (rnd < 4) { const int grp = xcd * 8 + rnd * 2 + (jx >> 4); b = grp >> 3; head = grp & 7; qrow0 = b * SEQ + (jx & 15) * 256; t0 = 0; }
        else { if (blockIdx.x >= 64) break; b = blockIdx.x >> 3; head = blockIdx.x & 7; qrow0 = NLAT + b * CTXL; t0 = 64; }
        unsigned doff[6];
#pragma unroll
        for (int i = 0; i < 6; ++i) { const int q = wave + 8 * i;
            if (q < 17) { const int ci = 64 * q + lane, rho = ci / 17, c = (ci % 17) & 15, ii = rho & 15, key = (rho & 32) + 8 * (ii >> 2) + 4 * ((rho >> 4) & 1) + (ii & 3); doff[i] = (unsigned)(key * D + head * 128 + 8 * c); }
            else if (q < 26) { const int ci = 64 * (q - 17) + lane, rho = ci / 9, c = (ci % 9) & 7, ii = rho & 15, key = (rho & 32) + 8 * (ii >> 2) + 4 * ((rho >> 4) & 1) + (ii & 3); doff[i] = (unsigned)(key * 64 + 8 * c); }
            else { const int ci = 64 * (q - 26) + lane, vcol = ci / 9, c = (ci % 9) & 7; doff[i] = (unsigned)((head * 128 + vcol) * MTOK + 8 * c); } }
#define ATT_DMA(t, buf) do { const int tok0 = (t) < 64 ? b * SEQ + (t) * 64 : NLAT + b * CTXL + ((t) - 64) * 64; \
            _Pragma("unroll") for (int i = 0; i < 6; ++i) { const int q = wave + 8 * i; \
                if (q < 17) __builtin_amdgcn_global_load_lds((const unsigned*)(KN + (size_t)tok0 * D + doff[i]), (LAS unsigned*)(lds + (buf) * ATT_STAGE + q * 1024), 16, 0, 0); \
                else if (q < 26) __builtin_amdgcn_global_load_lds((const unsigned*)(KR + (size_t)tok0 * 64 + doff[i]), (LAS unsigned*)(lds + (buf) * ATT_STAGE + KNBUF + (q - 17) * 1024), 16, 0, 0); \
                else if (q < 44) __builtin_amdgcn_global_load_lds((const unsigned*)(VT + (size_t)tok0 + doff[i]), (LAS unsigned*)(lds + (buf) * ATT_STAGE + KNBUF + KRBUF + (q - 26) * 1024), 16, 0, 0); } } while (0)
        bf16x8 qf[2][6];
#pragma unroll
        for (int g = 0; g < 2; ++g)
#pragma unroll
            for (int kk = 0; kk < 6; ++kk) qf[g][kk] = *(const bf16x8*)(QB + (size_t)(qrow0 + wave * 32 + g * 16 + fr) * 1536 + head * 192 + kk * 32 + fq * 8);
        if (rnd < 4) {
            const float* rope = (const float*)(p.ws + OFF_ROPE);
#pragma unroll
            for (int g = 0; g < 2; ++g) { const int pos = (qrow0 + wave * 32 + g * 16 + fr) & 4095;
#pragma unroll
                for (int kk = 4; kk < 6; ++kk) { const int P = kk == 5 ? (pos & 63) : (pos >> 6); const float* cs = rope + (P * 16 + (fq & 1) * 8) * 2; const float sg = (fq & 2) ? 1.0f : -1.0f;
                    u32x4 mine = __builtin_bit_cast(u32x4, qf[g][kk]), res;
#pragma unroll
                    for (int e = 0; e < 4; ++e) { const unsigned pw = (unsigned)__shfl_xor((int)mine[e], 32); const f32x4 c4 = *(const f32x4*)(cs + 4 * e);
                        const float r0 = bf_lo(mine[e]) * c4[0] + sg * bf_lo(pw) * c4[1], r1 = bf_hi(mine[e]) * c4[2] + sg * bf_hi(pw) * c4[3]; res[e] = pk_bf16(r0, r1); }
                    qf[g][kk] = __builtin_bit_cast(bf16x8, res); } }
        }
        f32x4 o[2][8]; float mrow[2], lrow[2];
#pragma unroll
        for (int g = 0; g < 2; ++g) { mrow[g] = -1e30f; lrow[g] = 0.f;
#pragma unroll
            for (int jb = 0; jb < 8; ++jb) o[g][jb] = (f32x4){0.f, 0.f, 0.f, 0.f}; }
        ATT_DMA(t0, 0); asm volatile("s_waitcnt vmcnt(0)" ::: "memory"); __syncthreads();
        for (int t = t0; t < 68; ++t) { const int cur = (t - t0) & 1;
            if (t + 1 < 68) ATT_DMA(t + 1, cur ^ 1);
            const LAS unsigned char* kb = lds + cur * ATT_STAGE; const LAS unsigned char* rb = kb + KNBUF; const LAS unsigned char* vb = rb + KRBUF;
            f32x4 s[2][4];
#pragma unroll
            for (int kt = 0; kt < 4; ++kt) { s[0][kt] = (f32x4){0.f, 0.f, 0.f, 0.f}; s[1][kt] = (f32x4){0.f, 0.f, 0.f, 0.f};
#pragma unroll
                for (int kk = 0; kk < 6; ++kk) { const bf16x8 kf = kk < 4 ? *(const LAS bf16x8*)(kb + (kt * 16 + fr) * KNROW + kk * 64 + fq * 16) : *(const LAS bf16x8*)(rb + (kt * 16 + fr) * KRROW + (kk - 4) * 64 + fq * 16);
                    s[0][kt] = __builtin_amdgcn_mfma_f32_16x16x32_bf16(kf, qf[0][kk], s[0][kt], 0, 0, 0);
                    s[1][kt] = __builtin_amdgcn_mfma_f32_16x16x32_bf16(kf, qf[1][kk], s[1][kt], 0, 0, 0); } }
            bf16x8 pf[2][2];
#pragma unroll
            for (int g = 0; g < 2; ++g) { float mx = -1e30f;
#pragma unroll
                for (int kt = 0; kt < 4; ++kt) mx = fmaxf(mx, fmaxf(fmaxf(s[g][kt][0], s[g][kt][1]), fmaxf(s[g][kt][2], s[g][kt][3])));
                mx = fmaxf(mx, __shfl_xor(mx, 16)); mx = fmaxf(mx, __shfl_xor(mx, 32));
                const float mn = fmaxf(mrow[g], mx), alpha = __builtin_amdgcn_exp2f(mrow[g] - mn); mrow[g] = mn; float ls = 0.f;
#pragma unroll
                for (int kt = 0; kt < 4; ++kt)
#pragma unroll
                    for (int e = 0; e < 4; ++e) { s[g][kt][e] = __builtin_amdgcn_exp2f(s[g][kt][e] - mn); ls += s[g][kt][e]; }
                lrow[g] = lrow[g] * alpha + ls;
#pragma unroll
                for (int jb = 0; jb < 8; ++jb) o[g][jb] *= alpha;
#pragma unroll
                for (int kg = 0; kg < 2; ++kg) { u32x4 w; w.x = pk_bf16(s[g][2 * kg][0], s[g][2 * kg][1]); w.y = pk_bf16(s[g][2 * kg][2], s[g][2 * kg][3]);
                    w.z = pk_bf16(s[g][2 * kg + 1][0], s[g][2 * kg + 1][1]); w.w = pk_bf16(s[g][2 * kg + 1][2], s[g][2 * kg + 1][3]); pf[g][kg] = __builtin_bit_cast(bf16x8, w); } }
#pragma unroll
            for (int kg = 0; kg < 2; ++kg)
#pragma unroll
                for (int jb = 0; jb < 8; ++jb) { const bf16x8 vf = *(const LAS bf16x8*)(vb + (jb * 16 + fr) * VROW + kg * 64 + fq * 16);
                    o[0][jb] = __builtin_amdgcn_mfma_f32_16x16x32_bf16(vf, pf[0][kg], o[0][jb], 0, 0, 0);
                    o[1][jb] = __builtin_amdgcn_mfma_f32_16x16x32_bf16(vf, pf[1][kg], o[1][jb], 0, 0, 0); }
            asm volatile("s_waitcnt vmcnt(0)" ::: "memory");
            __syncthreads();
        }
#undef ATT_DMA
#pragma unroll
        for (int g = 0; g < 2; ++g) { float lt = lrow[g]; lt += __shfl_xor(lt, 16); lt += __shfl_xor(lt, 32); const float inv = 1.0f / lt;
            bf16_t* op = AO + (size_t)(qrow0 + wave * 32 + g * 16 + fr) * D + head * 128 + 4 * fq;
#pragma unroll
            for (int jb = 0; jb < 8; ++jb) { const f32x4 v = o[g][jb] * inv; u32x2 w; w.x = pk_bf16(v[0], v[1]); w.y = pk_bf16(v[2], v[3]); *(u32x2*)(op + jb * 16) = w; } }
        __syncthreads();
    }
}

__global__ void __launch_bounds__(512) fwd_megakernel(Params p) {
    extern __shared__ __attribute__((aligned(16))) unsigned char smem[];
    cg::grid_group grid = cg::this_grid();
    LAS unsigned char* lds = (LAS unsigned char*)smem;
    bf16_t* W = (bf16_t*)(p.ws + OFF_W); float* H = (float*)(p.ws + OFF_H); bf16_t* A = (bf16_t*)(p.ws + OFF_A); unsigned char* BIG = p.ws + OFF_BIG;
    const float* modall = (const float*)(p.ws + OFF_MOD); const float* rope = (const float*)(p.ws + OFF_ROPE);
    phase_prologue(p, smem);
    convert_layer(p, smem, 0);
    grid.sync();
    for (int layer = 0; layer < 4; ++layer) {
        const float* modl = modall + (size_t)layer * 9 * (NMOD * D); const int j = layer >> 1;
        if (layer > 0) convert_layer(p, smem, layer);
        phase_norm(p, layer, 0, 0, layer == 0);
        grid.sync();
        { EpiGateUp e; e.hid = (bf16_t*)BIG; run_gemm(lds, A, W + W_GU0, MTOK, 2 * FH, D, e); }
        grid.sync();
        { EpiResid e; e.x = p.x; e.ctx = p.ctx; e.H = H; e.modl = modl; e.midx = 2; e.coef = 0.5f; e.from_input = (layer == 0); run_gemm(lds, (const bf16_t*)BIG, W + W_D0, MTOK, D, FH, e); }
        grid.sync();
        phase_norm(p, layer, 1, 3, 0);
        grid.sync();
        if ((layer & 1) == 0) {
            { EpiHgIn e; e.base = (u16*)BIG; e.lb = (const float*)(p.ws + OFF_LB) + j * 2048; run_gemm(lds, A, W + W_IN, MTOK, 5120, D, e); }
            grid.sync();
            phase_scan(p, smem);
            grid.sync();
            phase_readout(p, j);
            grid.sync();
            { EpiResid e; e.x = p.x; e.ctx = p.ctx; e.H = H; e.modl = modl; e.midx = 5; e.coef = 1.0f; e.from_input = 0; run_gemm(lds, (const bf16_t*)BIG, W + W_OUT, MTOK, D, D, e); }
        } else {
            bf16_t* QB = (bf16_t*)BIG; bf16_t* KN = QB + (size_t)MTOK * 1536; bf16_t* VT = KN + (size_t)MTOK * D; bf16_t* CQN = VT + (size_t)MTOK * D; bf16_t* CKVN = CQN + (size_t)MTOK * 384; bf16_t* KR = CKVN + (size_t)MTOK * 256;
            { EpiMlaDown e; e.dproj = (float*)BIG; e.kr = KR; e.rope = rope; run_gemm(lds, A, W + W_DN, MTOK, 768, D, e); }
            grid.sync();
            phase_mla_norm(p, j);
            grid.sync();
            { EpiBf16 e; e.o = QB; e.ldc = 1536; e.scale = QSCALE; run_gemm(lds, CQN, W + W_UQ, MTOK, 1536, 384, e); }
            { EpiBf16 e; e.o = KN; e.ldc = D; e.scale = 1.0f; run_gemm(lds, CKVN, W + W_K, MTOK, D, 256, e); }
            { EpiBf16 e; e.o = VT; e.ldc = MTOK; e.scale = 1.0f; run_gemm(lds, W + W_V, CKVN, D, MTOK, 256, e); }
            grid.sync();
            phase_attn(p, smem, layer != 3);
            grid.sync();
            { EpiResid e; e.x = p.x; e.ctx = p.ctx; e.H = H; e.modl = modl; e.midx = 5; e.coef = 1.0f; e.from_input = 0; run_gemm(lds, A, W + W_O, MTOK, D, D, e); }
        }
        grid.sync();
        phase_norm(p, layer, 2, 6, 0);
        grid.sync();
        { EpiGateUp e; e.hid = (bf16_t*)BIG; run_gemm(lds, A, W + W_GU1, MTOK, 2 * FH, D, e); }
        grid.sync();
        { EpiResid e; e.x = p.x; e.ctx = p.ctx; e.H = H; e.modl = modl; e.midx = 8; e.coef = 0.5f; e.from_input = 0; run_gemm(lds, (const bf16_t*)BIG, W + W_D1, MTOK, D, FH, e); }
        grid.sync();
    }
    phase_final(p);
}

extern "C" void kernel_launch(void* const* d_in, const int* in_sizes, int n_in, void* d_out, int out_size, void* d_ws, size_t ws_size, hipStream_t stream) {
    static int grid_blocks = 0;
    if (grid_blocks == 0) {
        if (n_in != 21 || out_size != NLAT * D || ws_size < WS_END) { fprintf(stderr, "kernel_launch: unexpected shapes (n_in %d out %d ws %zu need %zu)\n", n_in, out_size, ws_size, (size_t)WS_END); grid_blocks = -1; return; }
        int dev = 0, cus = 0, per_cu = 0;
        hipGetDevice(&dev); hipDeviceGetAttribute(&cus, hipDeviceAttributeMultiprocessorCount, dev);
        if (hipFuncSetAttribute((const void*)fwd_megakernel, hipFuncAttributeMaxDynamicSharedMemorySize, LDS_BYTES) != hipSuccess) { fprintf(stderr, "kernel_launch: hipFuncSetAttribute failed\n"); grid_blocks = -1; return; }
        hipOccupancyMaxActiveBlocksPerMultiprocessor(&per_cu, (const void*)fwd_megakernel, 512, LDS_BYTES);
        if (per_cu < 1) { fprintf(stderr, "kernel_launch: occupancy query says %d blocks per CU\n", per_cu); per_cu = 1; }
        (void)hipGetLastError();
        grid_blocks = cus;
    }
    if (grid_blocks < 0) return;
    Params p{};
    const float** pp = (const float**)&p;
    for (int i = 0; i < 21; ++i) pp[i] = (const float*)d_in[i];
    p.out = (float*)d_out; p.ws = (unsigned char*)d_ws;
    void* args[] = {&p};
    hipError_t e = hipLaunchCooperativeKernel((const void*)fwd_megakernel, dim3(grid_blocks), dim3(512), args, LDS_BYTES, stream);
    if (e != hipSuccess) fprintf(stderr, "cooperative launch failed: %s (grid %d)\n", hipGetErrorString(e), grid_blocks);
}
```

```cpp
#include <hip/hip_runtime.h>
#include <hip/hip_cooperative_groups.h>
#include <cstdio>
namespace cg = cooperative_groups;
namespace pg8 {
#define PG8_LAS __attribute__((address_space(3)))
typedef unsigned short bf16_t;
typedef short bf16x8 __attribute__((ext_vector_type(8)));
typedef float f32x4 __attribute__((ext_vector_type(4)));
typedef unsigned u32x4 __attribute__((ext_vector_type(4)));
constexpr int BM = 256, BK = 64, HALF = 128, HTB = HALF * BK * 2  , STAGE_BYTES = 8 * HTB, NXCD = 8, WGM = 8;

__host__ __device__ __forceinline__ int lds_byte(int r, int c) { const int st = (r >> 4) * 2 + (c >> 5), rr = r & 15, cc = c & 31, ob = rr * 64 + cc * 2; return st * 1024 + (ob ^ (((ob >> 9) & 1) << 5)); }
__host__ __device__ __forceinline__ void stage_rc(int b, int& R, int& C) { const int st = b / 1024, sb = b % 1024, swz = sb ^ (((sb >> 9) & 1) << 5); R = (st >> 1) * 16 + swz / 64; C = (st & 1) * 32 + (swz % 64) / 2; }
__host__ __device__ __forceinline__ int perm32(int rho) { const int n = rho >> 4, i = rho & 15; return 8 * (i >> 2) + 4 * n + (i & 3); }

struct Unit { int pm, pn; };
struct Gemm { const bf16_t* A; const bf16_t* Bt; int M, N, K, ld; };

struct StaticOrder {
    int nM, nN, nwg, G, c;
    __host__ __device__ void init(int M, int N, int G_, int c_) { nM = M / BM; nN = N / BM; nwg = nM * nN; G = G_; c = c_; }
    __host__ __device__ bool next(int i, Unit& u) const {
        const long L = (long)i * G + c; if (L >= nwg) return false;
        int wgid = (int)L; { const int q = nwg / NXCD, r = nwg % NXCD, xcd = wgid % NXCD, off = wgid / NXCD; wgid = (xcd < r ? xcd * (q + 1) : r * (q + 1) + (xcd - r) * q) + off; }
        const int nig = WGM * nN, gid = wgid / nig, fm = gid * WGM, gsz = (nM - fm) < WGM ? (nM - fm) : WGM;
        u.pm = fm + ((wgid % nig) % gsz); u.pn = (wgid % nig) / gsz; return true;
    }
    __device__ __forceinline__ void a_ready(const Unit&) const {}
    __device__ __forceinline__ void done(const Unit&) const {}
};
__device__ __forceinline__ unsigned cvt_pk_bf16(float lo, float hi) { unsigned r; asm volatile("v_cvt_pk_bf16_f32 %0, %1, %2" : "=v"(r) : "v"(lo), "v"(hi)); return r; }
typedef float f32x2 __attribute__((ext_vector_type(2)));
template <class Epi, class Sched, bool STAMP = false>
__device__ __forceinline__ void gemm_phase(PG8_LAS unsigned char* lds, const Gemm g, const Sched& S, const Epi& E, unsigned long long* stamps) {
    int tid_ = threadIdx.x; asm volatile("" : "+v"(tid_)); const int tid = tid_, wid = __builtin_amdgcn_readfirstlane(tid >> 6), lane = tid & 63, wr = wid >> 2, wc = wid & 3, fr = lane & 15, fq = lane >> 4;
    const int K = g.K, nt = K / BK, LD = g.ld;
    int ts_lo = 0, ts_hi = 0, nts = 0; const unsigned long long rt_entry = STAMP ? (unsigned long long)wall_clock64() : 0ull;
#define PG8_STAMP() do { if (STAMP && wid == 0 && nts < 64) { const unsigned long long _c = (unsigned long long)clock64(); \
        ts_lo = (lane == nts) ? (int)(unsigned)_c : ts_lo; ts_hi = (lane == nts) ? (int)(unsigned)(_c >> 32) : ts_hi; ++nts; } } while (0)
    PG8_STAMP();
    unsigned voffA[2], voffB[2];
#pragma unroll
    for (int i = 0; i < 2; ++i) { int R, C; stage_rc(tid * 16 + i * 8192, R, C); const int Rb = Epi::PERM ? ((R & ~31) + perm32(R & 31)) : R;
        voffA[i] = (unsigned)(R * LD + C) * 2u; voffB[i] = (unsigned)(Rb * LD + C) * 2u; }
    const size_t kstep = (size_t)(BK * 2);
    const size_t hstep = (size_t)HALF * LD * 2;
    const size_t tstep = 2 * hstep;
    const unsigned ldsw = (unsigned)wid * 1024u;
    const int aoff = lds_byte(wr * 64 + fr, fq * 8), boff = lds_byte(wc * 32 + fr, fq * 8);
#define PG8_SA(b, h) (((b) * 2 + (h)) * HTB)
#define PG8_SB(b, h) ((4 + (b) * 2 + (h)) * HTB)
#define PG8_STAGE(bufoff, gbase, voff) do { _Pragma("unroll") for (int _i = 0; _i < 2; ++_i) \
        __builtin_amdgcn_global_load_lds((const unsigned*)((const char*)(gbase) + (voff)[_i]), (PG8_LAS unsigned*)(lds + (bufoff) + ldsw + _i * 8192), 16, 0, 0); } while (0)
#define PG8_LDA(dst, b, h) do { _Pragma("unroll") for (int m = 0; m < 4; ++m) _Pragma("unroll") for (int k = 0; k < 2; ++k) dst[m][k] = *(const PG8_LAS bf16x8*)(lds + PG8_SA(b, h) + aoff + m * 2048 + k * 1024); } while (0)
#define PG8_LDB(dst, b, h) do { _Pragma("unroll") for (int n = 0; n < 2; ++n) _Pragma("unroll") for (int k = 0; k < 2; ++k) dst[n][k] = *(const PG8_LAS bf16x8*)(lds + PG8_SB(b, h) + boff + n * 2048 + k * 1024); } while (0)
#define PG8_MMA(ai, bj, At, Bt) do { __builtin_amdgcn_s_setprio(1); _Pragma("unroll") for (int m = 0; m < 4; ++m) _Pragma("unroll") for (int n = 0; n < 2; ++n) _Pragma("unroll") for (int k = 0; k < 2; ++k) \
        acc[ai][bj][m][n] = __builtin_amdgcn_mfma_f32_16x16x32_bf16(Bt[n][k], At[m][k], acc[ai][bj][m][n], 0, 0, 0); __builtin_amdgcn_s_setprio(0); } while (0)
#define PG8_WAIT_V(n) asm volatile("s_waitcnt vmcnt(" #n ")" ::: "memory")
#define PG8_WAIT_L(n) asm volatile("s_waitcnt lgkmcnt(" #n ")" ::: "memory")
#define PG8_BAR __builtin_amdgcn_s_barrier()
#define PG8_SCHED __builtin_amdgcn_sched_barrier(0)
    Unit cur, nxt; int ui = 0;
    if (!S.next(0, cur)) return;
    f32x4 acc[2][2][4][2];
#pragma unroll
    for (int a = 0; a < 2; ++a)
#pragma unroll
        for (int b = 0; b < 2; ++b)
#pragma unroll
            for (int m = 0; m < 4; ++m)
#pragma unroll
                for (int n = 0; n < 2; ++n) acc[a][b][m][n] = (f32x4){0.f, 0.f, 0.f, 0.f};
    bf16x8 At[4][2], B0[2][2], B1[2][2];
    const char* cA = (const char*)g.A + (size_t)cur.pm * tstep; const char* cB = (const char*)g.Bt + (size_t)cur.pn * tstep;
    S.a_ready(cur);
    PG8_STAGE(PG8_SB(0, 0), cB, voffB); PG8_STAGE(PG8_SA(0, 0), cA, voffA); PG8_STAGE(PG8_SB(0, 1), cB + hstep, voffB); PG8_STAGE(PG8_SA(0, 1), cA + hstep, voffA);
    if (wr == 1) PG8_BAR;
    PG8_WAIT_V(4); PG8_BAR;
    PG8_STAGE(PG8_SB(1, 0), cB + kstep, voffB); PG8_STAGE(PG8_SA(1, 0), cA + kstep, voffA); PG8_STAGE(PG8_SB(1, 1), cB + hstep + kstep, voffB);
    PG8_WAIT_V(6); PG8_BAR;
    PG8_STAMP();
    for (;;) {
        const bool has_next = S.next(ui + 1, nxt);
        const char* nA = has_next ? (const char*)g.A + (size_t)nxt.pm * tstep : cA; const char* nB = has_next ? (const char*)g.Bt + (size_t)nxt.pn * tstep : cB;
        for (int t = 0; t < nt; t += 2) {
            const bool last = (t == nt - 2);
            const char* a1 = cA + (size_t)(t + 1) * kstep;
            const char* a2 = last ? nA : cA + (size_t)(t + 2) * kstep; const char* b2 = last ? nB : cB + (size_t)(t + 2) * kstep;
            const char* a3 = a2 + kstep; const char* b3 = b2 + kstep;
            if (last && has_next) S.a_ready(nxt);
            PG8_LDB(B0, 0, 0); PG8_SCHED; PG8_LDA(At, 0, 0); PG8_STAGE(PG8_SA(1, 1), a1 + hstep, voffA);
            PG8_WAIT_L(8); PG8_BAR; PG8_WAIT_L(0); PG8_MMA(0, 0, At, B0); PG8_BAR; PG8_SCHED;
            PG8_LDB(B1, 0, 1); PG8_STAGE(PG8_SB(0, 0), b2, voffB);
            PG8_BAR; PG8_WAIT_L(0); PG8_MMA(0, 1, At, B1); PG8_BAR;
            PG8_LDA(At, 0, 1); PG8_STAGE(PG8_SA(0, 0), a2, voffA);
            PG8_BAR; PG8_WAIT_L(0); PG8_MMA(1, 0, At, B0); PG8_BAR; PG8_SCHED;
            PG8_STAGE(PG8_SB(0, 1), b2 + hstep, voffB);
            PG8_WAIT_V(6); PG8_BAR; PG8_MMA(1, 1, At, B1); PG8_BAR;
            PG8_LDB(B0, 1, 0); PG8_SCHED; PG8_LDA(At, 1, 0); PG8_STAGE(PG8_SA(0, 1), a2 + hstep, voffA);
            PG8_WAIT_L(8); PG8_BAR; PG8_WAIT_L(0); PG8_MMA(0, 0, At, B0); PG8_BAR; PG8_SCHED;
            PG8_LDB(B1, 1, 1); PG8_STAGE(PG8_SB(1, 0), b3, voffB);
            PG8_BAR; PG8_WAIT_L(0); PG8_MMA(0, 1, At, B1); PG8_BAR;
            PG8_LDA(At, 1, 1); PG8_STAGE(PG8_SA(1, 0), a3, voffA);
            PG8_BAR; PG8_WAIT_L(0); PG8_MMA(1, 0, At, B0); PG8_BAR; PG8_SCHED;
            PG8_STAGE(PG8_SB(1, 1), b3 + hstep, voffB);
            PG8_WAIT_V(6); PG8_BAR; PG8_MMA(1, 1, At, B1); PG8_BAR;
        }
        PG8_STAMP();
        if constexpr (!Epi::AFTER_DRAIN) { E(acc, cur, wr, wc, fr, fq); S.done(cur); }
        PG8_STAMP();
        if (!has_next) break;
#pragma unroll
        for (int a = 0; a < 2; ++a)
#pragma unroll
            for (int b = 0; b < 2; ++b)
#pragma unroll
                for (int m = 0; m < 4; ++m)
#pragma unroll
                    for (int n = 0; n < 2; ++n) acc[a][b][m][n] = (f32x4){0.f, 0.f, 0.f, 0.f};
        cur = nxt; cA = nA; cB = nB; ++ui;
    }
    PG8_WAIT_V(0);
    if (wr == 0) PG8_BAR;
    PG8_BAR;
    if constexpr (Epi::AFTER_DRAIN) { E.fused(acc, cur, wr, wc, fr, fq, lds, wid, lane); S.done(cur); }
    PG8_STAMP();
    if (STAMP && wid == 0) { stamps[lane] = lane < nts ? (((unsigned long long)(unsigned)ts_hi << 32) | (unsigned)ts_lo) : 0ull;
        if (lane == 62) stamps[62] = rt_entry; if (lane == 63) stamps[63] = (unsigned long long)wall_clock64(); }
#undef PG8_STAMP
#undef PG8_SA
#undef PG8_SB
#undef PG8_STAGE
#undef PG8_LDA
#undef PG8_LDB
#undef PG8_MMA
#undef PG8_WAIT_V
#undef PG8_WAIT_L
#undef PG8_BAR
#undef PG8_SCHED
}
}

typedef pg8::bf16_t bf16_t;
typedef pg8::bf16x8 bf16x8;
typedef pg8::f32x4 f32x4;
typedef unsigned short u16;
typedef unsigned u32x2 __attribute__((ext_vector_type(2)));
typedef unsigned u32x4 __attribute__((ext_vector_type(4)));
typedef float f32x2 __attribute__((ext_vector_type(2)));
#define LAS __attribute__((address_space(3)))

constexpr int D = 1024, NLAT = 32768, NCTX = 2048, MTOK = 34816, SEQ = 4096, CTXL = 256, FH = 2816, NMOD = 9;
constexpr int LDS_MAIN = 157696, LDS_BYTES = LDS_MAIN + 16;
constexpr size_t OFF_MOD = 4096, OFF_LB = 1331200, OFF_ROPE = 1347584, OFF_BAR = 1355776, OFF_W = 2097152, OFF_H = 50331648, OFF_A = 192937984, OFF_BIG = 264241152;
constexpr size_t T16 = 71303168;
constexpr size_t WS_END = OFF_BIG + 5 * T16;
constexpr size_t W_GU0 = 0, W_D0 = 5767168, W_GU1 = 8650752, W_D1 = 14417920, W_MIX = 17301504;
constexpr size_t W_IN = W_MIX, W_OUT = W_MIX + 5242880;
constexpr size_t W_DN = W_MIX, W_UQ = W_MIX + 786432, W_K = W_MIX + 1376256, W_V = W_MIX + 1638400, W_O = W_MIX + 1900544;
constexpr float QSCALE = 0.07216878364870322f * 1.4426950408889634f;

struct Params {
    const float *x, *c, *ctx, *c_ctx, *mod_w, *mod_b, *norm_g, *w_gate, *w_up, *w_down, *hg_w_in, *hg_w_out, *hg_gn, *hg_lb, *mla_w_down, *mla_q_norm, *mla_w_uq, *mla_kv_norm, *mla_w_ukv, *mla_w_o, *final_g;
    float* out; unsigned char* ws;
};

__device__ __forceinline__ int fresh_tid() { int t = threadIdx.x; asm volatile("" : "+v"(t)); return t; }
__device__ __forceinline__ unsigned pk_bf16(float lo, float hi) { unsigned r; asm volatile("v_cvt_pk_bf16_f32 %0, %1, %2" : "=v"(r) : "v"(lo), "v"(hi)); return r; }
__device__ __forceinline__ float bf_lo(unsigned w) { return __uint_as_float(w << 16); }
__device__ __forceinline__ float bf_hi(unsigned w) { return __uint_as_float(w & 0xffff0000u); }
__device__ __forceinline__ float sigmoidf_(float x) { return __builtin_amdgcn_rcpf(1.0f + __expf(-x)); }
__device__ __forceinline__ float siluf_(float x) { return x * sigmoidf_(x); }
__device__ __forceinline__ float rows_max(float v) {
    u32x2 a = __builtin_amdgcn_permlane32_swap(__float_as_uint(v), __float_as_uint(v), false, false); v = fmaxf(__uint_as_float(a.x), __uint_as_float(a.y));
    u32x2 b = __builtin_amdgcn_permlane16_swap(__float_as_uint(v), __float_as_uint(v), false, false); return fmaxf(__uint_as_float(b.x), __uint_as_float(b.y)); }
__device__ __forceinline__ float max3f(float a, float b, float c) { float r; asm("v_max3_f32 %0, %1, %2, %3" : "=v"(r) : "v"(a), "v"(b), "v"(c)); return r; }
__device__ __forceinline__ float wave_sum(float v) {
#pragma unroll
    for (int o = 1; o < 64; o <<= 1) v += __shfl_xor(v, o);
    return v;
}
__device__ __forceinline__ const float* in_row(const Params& p, int row) { return row < NLAT ? p.x + (size_t)row * D : p.ctx + (size_t)(row - NLAT) * D; }
__device__ __forceinline__ int mod_row(int row) { return row < NLAT ? (row >> 12) : 8; }


#define XB_TMO      128
#define XB_XCNT(j)  (256  + 64 * (j))
#define XB_XSUB(j)  (1280 + 64 * (j))
#define XB_XGEN(j)  (2304 + 64 * (j))
#define XB_TOP      3328
#define XB_TOPGEN   3392
#define XCD_BAR_WORDS 3456
#define XB_SPIN_CAP (1u << 22)
__device__ __forceinline__ unsigned xb_ld(unsigned* p)              { return __hip_atomic_load(p, __ATOMIC_RELAXED, __HIP_MEMORY_SCOPE_AGENT); }
__device__ __forceinline__ unsigned xb_add(unsigned* p, unsigned v) { return __hip_atomic_fetch_add(p, v, __ATOMIC_RELAXED, __HIP_MEMORY_SCOPE_AGENT); }
__device__ __forceinline__ unsigned xb_xcc_id() { return (unsigned)__builtin_amdgcn_s_getreg((3 << 11) | 20) & 0xFu; }
#define XB_SPIN(cond, bar) do { unsigned _sp = 0; while (cond) { __builtin_amdgcn_s_sleep(1); \
    if ((++_sp & 255u) == 0u) { if (xb_ld(&(bar)[XB_TMO])) break; if (_sp > XB_SPIN_CAP) { atomicAdd(&(bar)[XB_TMO], 1u); break; } } } } while (0)
struct XcdBarrier { unsigned* bar; unsigned x; volatile LAS unsigned* st; };
__device__ __forceinline__ XcdBarrier xcd_barrier_post(unsigned* bar, volatile LAS unsigned* st) {
    XcdBarrier b; b.bar = bar; b.x = xb_xcc_id(); b.st = st;
    if (threadIdx.x == 0) (void)xb_add(&bar[XB_XCNT(b.x)], 1u);
    return b;
}
__device__ __forceinline__ void xcd_barrier_complete(unsigned* bar, unsigned x, unsigned& nloc, unsigned& nx) {
    const unsigned G = gridDim.x * gridDim.y * gridDim.z;
    unsigned sum, cnt, mine, sp = 0u;
    for (;;) {
        sum = 0u; cnt = 0u; mine = 0u;
#pragma unroll
        for (unsigned j = 0; j < 16; ++j) { const unsigned c = xb_ld(&bar[XB_XCNT(j)]); sum += c; cnt += (c > 0u) ? 1u : 0u; mine = (j == x) ? c : mine; }
        if (sum == G) break;
        __builtin_amdgcn_s_sleep(1);
        if ((++sp & 255u) == 0u) { if (xb_ld(&bar[XB_TMO])) break; if (sp > XB_SPIN_CAP) { atomicAdd(&bar[XB_TMO], 1u); break; } }
    }
    nloc = mine > 0u ? mine : 1u; nx = cnt > 0u ? cnt : 1u;
}
__device__ __forceinline__ void xcd_barrier(const XcdBarrier& b) {
    asm volatile("s_waitcnt vmcnt(0)" ::: "memory");
    __syncthreads();
    if (threadIdx.x == 0) {
        unsigned* bar = b.bar;
        __builtin_amdgcn_s_waitcnt(0);
        unsigned nloc = b.st[0], nx = b.st[1];
        if (nloc == 0u) { xcd_barrier_complete(bar, b.x, nloc, nx); b.st[0] = nloc; b.st[1] = nx; }
        const unsigned old = xb_add(&bar[XB_XSUB(b.x)], 1u);
        const unsigned gen = old / nloc;
        if (old + 1u == (gen + 1u) * nloc) {
            __builtin_amdgcn_fence(__ATOMIC_RELEASE, "agent");
            asm volatile("s_waitcnt vmcnt(0)" ::: "memory");
            const unsigned og = xb_add(&bar[XB_TOP], 1u);
            const unsigned tg = og / nx;
            if (og + 1u == (tg + 1u) * nx) xb_add(&bar[XB_TOPGEN], 1u);
            else XB_SPIN(xb_ld(&bar[XB_TOPGEN]) == tg, bar);
            __builtin_amdgcn_fence(__ATOMIC_ACQUIRE, "agent");
            xb_add(&bar[XB_XGEN(b.x)], 1u);
            asm volatile("s_waitcnt vmcnt(0)" ::: "memory");
        } else {
            XB_SPIN(xb_ld(&bar[XB_XGEN(b.x)]) == gen, bar);
            __builtin_amdgcn_fence(__ATOMIC_ACQUIRE, "agent");
            asm volatile("s_waitcnt vmcnt(0)" ::: "memory");
        }
    }
    __syncthreads();
}

#define EPI_ARGS const f32x4 (&acc)[2][2][4][2], const pg8::Unit& u, int wr, int wc, int fr, int fq
struct EpiGateUp {
    static constexpr bool PERM = false, AFTER_DRAIN = false; bf16_t* hid;
    __device__ __forceinline__ void operator()(EPI_ARGS) const {
        const int row0 = u.pm * 256 + wr * 64 + fr, hc0 = u.pn * 128 + wc * 16 + 4 * fq;
#pragma unroll
        for (int ai = 0; ai < 2; ++ai)
#pragma unroll
            for (int m = 0; m < 4; ++m) { bf16_t* rp = hid + (size_t)(row0 + ai * 128 + m * 16) * FH + hc0;
#pragma unroll
                for (int bj = 0; bj < 2; ++bj) { const f32x4 g = acc[ai][bj][m][0], up = acc[ai][bj][m][1];
                    u32x2 w; w.x = pk_bf16(siluf_(g[0]) * up[0], siluf_(g[1]) * up[1]); w.y = pk_bf16(siluf_(g[2]) * up[2], siluf_(g[3]) * up[3]);
                    *(u32x2*)(rp + bj * 64) = w; } }
    }
};
struct EpiResid {
    static constexpr bool PERM = false, AFTER_DRAIN = false; const float* x; const float* ctx; float* H; const float* modl; int midx; float coef; int from_input; int row_off;
    __device__ __forceinline__ void operator()(EPI_ARGS) const {
        const int row0 = u.pm * 256 + wr * 64 + fr, col0 = u.pn * 256 + wc * 32 + 4 * fq;
        const float* mv = modl + (size_t)mod_row(u.pm * 256) * (NMOD * D) + midx * D + col0;
        f32x4 mm[2][2];
#pragma unroll
        for (int bj = 0; bj < 2; ++bj)
#pragma unroll
            for (int n = 0; n < 2; ++n) mm[bj][n] = *(const f32x4*)(mv + bj * 128 + n * 16) * coef;
#pragma unroll
        for (int ai = 0; ai < 2; ++ai)
#pragma unroll
            for (int m = 0; m < 4; ++m) { const int row = row0 + ai * 128 + m * 16;
                const float* sp = (from_input ? (row < NLAT ? x + (size_t)row * D : ctx + (size_t)(row - NLAT) * D) : H + (size_t)row * D) + col0; float* dp = H + (size_t)row * D + col0;
#pragma unroll
                for (int bj = 0; bj < 2; ++bj)
#pragma unroll
                    for (int n = 0; n < 2; ++n) { const f32x4 s = *(const f32x4*)(sp + bj * 128 + n * 16); *(f32x4*)(dp + bj * 128 + n * 16) = s + mm[bj][n] * acc[ai][bj][m][n]; }
                asm volatile("" ::: "memory"); }
    }
};
struct EpiF32Part {
    static constexpr bool PERM = false, AFTER_DRAIN = false; float* P;
    __device__ __forceinline__ void operator()(EPI_ARGS) const {
        const int row0 = u.pm * 256 + wr * 64 + fr, col0 = u.pn * 256 + wc * 32 + 4 * fq;
#pragma unroll
        for (int ai = 0; ai < 2; ++ai)
#pragma unroll
            for (int m = 0; m < 4; ++m) { float* dp = P + (size_t)(row0 + ai * 128 + m * 16) * D + col0;
#pragma unroll
                for (int bj = 0; bj < 2; ++bj)
#pragma unroll
                    for (int n = 0; n < 2; ++n) *(f32x4*)(dp + bj * 128 + n * 16) = acc[ai][bj][m][n]; }
    }
};
struct EpiHgIn {
    static constexpr bool PERM = false, AFTER_DRAIN = false; u16* base; const float* lb;
    __device__ __forceinline__ void operator()(EPI_ARGS) const {
        const int kind = u.pn >> 2; const int row0 = u.pm * 256 + wr * 64 + fr, col0 = (u.pn & 3) * 256 + wc * 32 + 4 * fq;
        u16* dst = base + (size_t)kind * (T16 / 2);
        if (kind == 1 || kind == 2) {
            f32x4 l4[2][2], s4[2][2];
#pragma unroll
            for (int bj = 0; bj < 2; ++bj)
#pragma unroll
                for (int n = 0; n < 2; ++n) { l4[bj][n] = *(const f32x4*)(lb + (kind - 1) * D + col0 + bj * 128 + n * 16); s4[bj][n] = (1.0f - l4[bj][n]) * 65535.0f; l4[bj][n] = l4[bj][n] * 65535.0f + 0.5f; }
#pragma unroll
            for (int ai = 0; ai < 2; ++ai)
#pragma unroll
                for (int m = 0; m < 4; ++m) { u16* rp = dst + (size_t)(row0 + ai * 128 + m * 16) * D + col0;
#pragma unroll
                    for (int bj = 0; bj < 2; ++bj)
#pragma unroll
                        for (int n = 0; n < 2; ++n) { const f32x4 v = acc[ai][bj][m][n]; unsigned q[4];
#pragma unroll
                            for (int e = 0; e < 4; ++e) q[e] = (unsigned)(l4[bj][n][e] + s4[bj][n][e] * sigmoidf_(v[e]));
                            u32x2 w; w.x = q[0] | (q[1] << 16); w.y = q[2] | (q[3] << 16); *(u32x2*)(rp + bj * 128 + n * 16) = w; } }
        } else {
#pragma unroll
            for (int ai = 0; ai < 2; ++ai)
#pragma unroll
                for (int m = 0; m < 4; ++m) { u16* rp = dst + (size_t)(row0 + ai * 128 + m * 16) * D + col0;
#pragma unroll
                    for (int bj = 0; bj < 2; ++bj)
#pragma unroll
                        for (int n = 0; n < 2; ++n) { const f32x4 v = acc[ai][bj][m][n]; u32x2 w;
                            if (kind == 4) { w.x = pk_bf16(siluf_(v[0]), siluf_(v[1])); w.y = pk_bf16(siluf_(v[2]), siluf_(v[3])); }
                            else { w.x = pk_bf16(v[0], v[1]); w.y = pk_bf16(v[2], v[3]); }
                            *(u32x2*)(rp + bj * 128 + n * 16) = w; } }
        }
    }
};
struct EpiMlaDown {
    static constexpr bool PERM = false, AFTER_DRAIN = false; float* dproj; bf16_t* kr; const float* rope;
    __device__ __forceinline__ void operator()(EPI_ARGS) const {
        const int row0 = u.pm * 256 + wr * 64 + fr;
#pragma unroll
        for (int bj = 0; bj < 2; ++bj) { const int gcol = u.pn * 256 + bj * 128 + wc * 32;
            if (gcol < 640) {
#pragma unroll
                for (int ai = 0; ai < 2; ++ai)
#pragma unroll
                    for (int m = 0; m < 4; ++m) { float* rp = dproj + (size_t)(row0 + ai * 128 + m * 16) * 640 + gcol + 4 * fq;
                        *(f32x4*)rp = acc[ai][bj][m][0]; *(f32x4*)(rp + 16) = acc[ai][bj][m][1]; }
            } else if (gcol < 704) { const int axis = (gcol - 640) >> 5;
#pragma unroll
                for (int ai = 0; ai < 2; ++ai)
#pragma unroll
                    for (int m = 0; m < 4; ++m) { const int row = row0 + ai * 128 + m * 16; f32x4 a = acc[ai][bj][m][0], b = acc[ai][bj][m][1];
                        if (row < NLAT) { const int pos = row & 4095, P = axis ? (pos & 63) : (pos >> 6); const float* cs = rope + (P * 16 + 4 * fq) * 2;
                            const f32x4 c0 = *(const f32x4*)cs, c1 = *(const f32x4*)(cs + 4);
                            const f32x4 cv = {c0[0], c0[2], c1[0], c1[2]}, sv = {c0[1], c0[3], c1[1], c1[3]};
                            const f32x4 na = a * cv - b * sv, nb = a * sv + b * cv; a = na; b = nb; }
                        bf16_t* rp = kr + (size_t)row * 64 + axis * 32 + 4 * fq; u32x2 w;
                        w.x = pk_bf16(a[0], a[1]); w.y = pk_bf16(a[2], a[3]); *(u32x2*)rp = w;
                        w.x = pk_bf16(b[0], b[1]); w.y = pk_bf16(b[2], b[3]); *(u32x2*)(rp + 16) = w; asm volatile("" ::: "memory"); }
            }
        }
    }
};
struct EpiBf16 {
    static constexpr bool PERM = false, AFTER_DRAIN = false; bf16_t* o; size_t ldc; float scale;
    __device__ __forceinline__ void operator()(EPI_ARGS) const {
        const int row0 = u.pm * 256 + wr * 64 + fr, col0 = u.pn * 256 + wc * 32 + 4 * fq;
#pragma unroll
        for (int ai = 0; ai < 2; ++ai)
#pragma unroll
            for (int m = 0; m < 4; ++m) { bf16_t* rp = o + (size_t)(row0 + ai * 128 + m * 16) * ldc + col0;
#pragma unroll
                for (int bj = 0; bj < 2; ++bj)
#pragma unroll
                    for (int n = 0; n < 2; ++n) { const f32x4 v = acc[ai][bj][m][n] * scale; u32x2 w; w.x = pk_bf16(v[0], v[1]); w.y = pk_bf16(v[2], v[3]); *(u32x2*)(rp + bj * 128 + n * 16) = w; } }
    }
};
template <class Epi> __device__ __forceinline__ void run_gemm(LAS unsigned char* lds, const bf16_t* A, const bf16_t* Bt, int M, int N, int K, const Epi& E, int ld = 0, int rot = 0) {
    pg8::Gemm g; g.A = A; g.Bt = Bt; g.M = M; g.N = N; g.K = K; g.ld = ld ? ld : K;
    pg8::StaticOrder S; S.init(M, N, gridDim.x, (blockIdx.x + gridDim.x - rot) % gridDim.x);
    pg8::gemm_phase<Epi, pg8::StaticOrder, false>(lds, g, S, E, nullptr);
}
template <int KTOT> __device__ __forceinline__ void resid_latent(LAS unsigned char* lds, const Params& p, const bf16_t* A, const bf16_t* Wt, float* H, const float* modl, int midx, float coef, int from_input) {
    EpiResid e; e.x = p.x; e.ctx = p.ctx; e.H = H; e.modl = modl; e.midx = midx; e.coef = coef; e.from_input = from_input; e.row_off = 0; run_gemm(lds, A, Wt, NLAT, D, KTOT, e);
}
template <int KTOT> __device__ __forceinline__ void resid_ctx(LAS unsigned char* lds, const bf16_t* A, const bf16_t* Wt, float* P) {
    EpiF32Part e; e.P = P; run_gemm(lds, A + (size_t)NLAT * KTOT, Wt, NCTX, D, KTOT, e, KTOT, 0);
}

__device__ __forceinline__ const float* conv_src(int kind, const float* s0, const float* s1, int R) {
    switch (kind) {
        case 1: return ((R >> 4) & 1 ? s1 : s0) + (R >> 5) * 16 + (R & 15);
        case 2: return s0 + (R >> 7) * 256 + (R & 127);
        case 3: return s0 + (R >> 7) * 256 + 128 + (R & 127);
        case 4: return R < 704 ? s0 + R : nullptr;
        default: return s0 + R;
    }
}
__device__ __forceinline__ void conv_T(unsigned char* smem, int kind, const float* s0, const float* s1, int ldn, int Ndst, int K, bf16_t* dst, int rot, int wg_lo = 0) {
    float* tile = (float*)smem;
    const int tid = fresh_tid(), nkb = K / 64, ntiles = (Ndst / 64) * nkb, G = (int)gridDim.x - wg_lo;
    for (int t = ((int)blockIdx.x - wg_lo + rot) % G; t < ntiles; t += G) {
        const int R0 = (t / nkb) * 64, k0 = (t % nkb) * 64;
        { const int Rl = tid & 63, kr = tid >> 6; const float* sp = conv_src(kind, s0, s1, R0 + Rl);
#pragma unroll
            for (int ps = 0; ps < 8; ++ps) { const int kl = ps * 8 + kr; tile[Rl * 65 + kl] = sp ? sp[(size_t)(k0 + kl) * ldn] : 0.f; } }
        __syncthreads();
        { const int Rl = tid >> 3, c = tid & 7; const float* s = tile + Rl * 65 + 8 * c; u32x4 w;
            w.x = pk_bf16(s[0], s[1]); w.y = pk_bf16(s[2], s[3]); w.z = pk_bf16(s[4], s[5]); w.w = pk_bf16(s[6], s[7]);
            *(u32x4*)(dst + (size_t)(R0 + Rl) * K + k0 + 8 * c) = w; }
        __syncthreads();
    }
}
__device__ __forceinline__ void convert_layer(const Params& p, unsigned char* smem, int layer, int part = 3, int wg_lo = 0) {
    bf16_t* W = (bf16_t*)(p.ws + OFF_W);
    for (int s = 0; s < 2; ++s) {
        const size_t o = ((size_t)layer * 2 + s) * D * FH;
        if (part & 1) conv_T(smem, 1, p.w_gate + o, p.w_up + o, FH, 2 * FH, D, W + (s ? W_GU1 : W_GU0), s * 64, wg_lo);
        if (part & (s ? 2 : 1)) conv_T(smem, 0, p.w_down + o, nullptr, D, D, FH, W + (s ? W_D1 : W_D0), s * 64 + 32, wg_lo);
    }
    if (!(part & 1)) return;
    const int j = layer >> 1;
    if ((layer & 1) == 0) {
        conv_T(smem, 0, p.hg_w_in + (size_t)j * D * 5120, nullptr, 5120, 5120, D, W + W_IN, 128, wg_lo);
        conv_T(smem, 0, p.hg_w_out + (size_t)j * D * D, nullptr, D, D, D, W + W_OUT, 160, wg_lo);
    } else {
        conv_T(smem, 4, p.mla_w_down + (size_t)j * D * 704, nullptr, 704, 768, D, W + W_DN, 128, wg_lo);
        conv_T(smem, 0, p.mla_w_uq + (size_t)j * 384 * 1536, nullptr, 1536, 1536, 384, W + W_UQ, 176, wg_lo);
        conv_T(smem, 2, p.mla_w_ukv + (size_t)j * 256 * 2048, nullptr, 2048, 1024, 256, W + W_K, 200, wg_lo);
        conv_T(smem, 3, p.mla_w_ukv + (size_t)j * 256 * 2048, nullptr, 2048, 1024, 256, W + W_V, 216, wg_lo);
        conv_T(smem, 0, p.mla_w_o + (size_t)j * D * D, nullptr, D, D, D, W + W_O, 232, wg_lo);
    }
}
__device__ __forceinline__ void phase_prologue(const Params& p, unsigned char* smem, int l0, int l1, int wg_lo, bool tables) {
    float* sS = (float*)smem;
    float* sP = sS + 9 * 1024;
    const int tid = fresh_tid(), wave = tid >> 6, lane = tid & 63;
    for (int i = tid; i < 9 * 1024; i += 512) { const float v = i < 8192 ? p.c[i] : p.c_ctx[i - 8192]; sS[i] = siluf_(v); }
    __syncthreads();
    float* mod = (float*)(p.ws + OFF_MOD);
    for (int item = (int)blockIdx.x - wg_lo; item < (l1 - l0) * 144; item += (int)gridDim.x - wg_lo) {
        const int l = l0 + item / 144, j0 = (item % 144) * 64; const float* wp = p.mod_w + (size_t)l * D * (NMOD * D) + j0 + lane;
        float a[9];
#pragma unroll
        for (int r = 0; r < 9; ++r) a[r] = 0.f;
#pragma unroll 8
        for (int kk = 0; kk < 128; ++kk) { const int k = wave * 128 + kk; const float w = wp[(size_t)k * (NMOD * D)];
#pragma unroll
            for (int r = 0; r < 9; ++r) a[r] += sS[r * 1024 + k] * w; }
#pragma unroll
        for (int r = 0; r < 9; ++r) sP[(wave * 9 + r) * 64 + lane] = a[r];
        __syncthreads();
        for (int i = tid; i < 9 * 64; i += 512) { const int r = i >> 6, jl = i & 63; float s = p.mod_b[(size_t)l * (NMOD * D) + j0 + jl];
#pragma unroll
            for (int w = 0; w < 8; ++w) s += sP[(w * 9 + r) * 64 + jl];
            mod[((size_t)l * 9 + r) * (NMOD * D) + j0 + jl] = s; }
        __syncthreads();
    }
    if (!tables) return;
    const int gt = blockIdx.x * 512 + tid;
    if (gt < 4096) { float* lb = (float*)(p.ws + OFF_LB); const int idx = gt & 2047;
        if (gt < 2048) lb[gt] = 0.f; else lb[gt] = sigmoidf_(p.hg_lb[2048 + idx] - p.hg_lb[idx]); }
    if (gt >= 4096 && gt < 4096 + 1024) { float* rt = (float*)(p.ws + OFF_ROPE); const int i = gt - 4096, P = i >> 4, j = i & 15;
        const float inv = exp2f(-(float)j * (13.287712379549449f / 16.0f)); const float xa = (float)P * inv;
        const float kq = __builtin_rintf(xa * 0.15915494309189535f); float r = fmaf(-kq, 6.28125f, xa); r = fmaf(-kq, 1.9353071795864769e-3f, r);
        rt[2 * i] = cosf(r); rt[2 * i + 1] = sinf(r); }
}
__device__ __forceinline__ void phase_norm(const Params& p, int layer, int gi, int mbase, int from_input, const float* P, int player, int pmidx, float pcoef, int ctx_from_input, int row_lo, int row_hi, int wg_lo) {
    const int tid = fresh_tid(); const int lane = tid & 63, gw = ((int)blockIdx.x - wg_lo) * 8 + (tid >> 6), nw = ((int)gridDim.x - wg_lo) * 8;
    const float* H = (const float*)(p.ws + OFF_H); bf16_t* A = (bf16_t*)(p.ws + OFF_A);
    const float* modl = (const float*)(p.ws + OFF_MOD) + (size_t)layer * 9 * (NMOD * D); const float* g = p.norm_g + ((size_t)layer * 3 + gi) * D;
    const int chunk = (row_hi - row_lo + nw - 1) / nw; const int r0 = row_lo + gw * chunk, r1 = (r0 + chunk < row_hi) ? r0 + chunk : row_hi;
    f32x4 gs[4], sh[4]; int cur_mr = -1;
    for (int row = r0; row < r1; ++row) {
        const float* hp = (from_input || (ctx_from_input && row >= NLAT)) ? in_row(p, row) : H + (size_t)row * D;
        const int mrow_i = mod_row(row);
        if (mrow_i != cur_mr) { cur_mr = mrow_i; const float* mr = modl + (size_t)mrow_i * (NMOD * D) + mbase * D;
#pragma unroll
            for (int j = 0; j < 4; ++j) { const int c = 4 * lane + 256 * j; gs[j] = *(const f32x4*)(g + c) * (*(const f32x4*)(mr + D + c) + 1.0f); sh[j] = *(const f32x4*)(mr + c); } }
        f32x4 v[4]; float s = 0.f;
#pragma unroll
        for (int j = 0; j < 4; ++j) v[j] = *(const f32x4*)(hp + 4 * lane + 256 * j);
        if (P != nullptr && row >= NLAT) {
            const float* pr = P + (size_t)(row - NLAT) * D; const float* pm = (const float*)(p.ws + OFF_MOD) + ((size_t)player * 9 + 8) * (NMOD * D) + pmidx * D; float* hw = (float*)(p.ws + OFF_H) + (size_t)row * D;
#pragma unroll
            for (int j = 0; j < 4; ++j) { const int c = 4 * lane + 256 * j; const f32x4 t = *(const f32x4*)(pr + c);
                v[j] = v[j] + (*(const f32x4*)(pm + c) * pcoef) * t; *(f32x4*)(hw + c) = v[j]; }
        }
#pragma unroll
        for (int j = 0; j < 4; ++j) s += (v[j][0] * v[j][0] + v[j][1] * v[j][1]) + (v[j][2] * v[j][2] + v[j][3] * v[j][3]);
        const float rstd = __builtin_amdgcn_rsqf(wave_sum(s) * (1.0f / D) + 1e-6f);
#pragma unroll
        for (int j = 0; j < 4; ++j) { const int c = 4 * lane + 256 * j;
            const f32x4 y = (v[j] * rstd) * gs[j] + sh[j]; u32x2 w; w.x = pk_bf16(y[0], y[1]); w.y = pk_bf16(y[2], y[3]); *(u32x2*)(A + (size_t)row * D + c) = w; }
    }
}
__device__ __forceinline__ void phase_final(const Params& p) {
    const int tid = fresh_tid(); const int lane = tid & 63, gw = blockIdx.x * 8 + (tid >> 6), nw = gridDim.x * 8; const float* H = (const float*)(p.ws + OFF_H);
    for (int row = gw; row < NLAT; row += nw) { const float* hp = H + (size_t)row * D; f32x4 v[4]; float s = 0.f;
#pragma unroll
        for (int j = 0; j < 4; ++j) { v[j] = *(const f32x4*)(hp + 4 * lane + 256 * j); s += (v[j][0] * v[j][0] + v[j][1] * v[j][1]) + (v[j][2] * v[j][2] + v[j][3] * v[j][3]); }
        const float rstd = __builtin_amdgcn_rsqf(wave_sum(s) * (1.0f / D) + 1e-6f);
#pragma unroll
        for (int j = 0; j < 4; ++j) { const int c = 4 * lane + 256 * j; *(f32x4*)(p.out + (size_t)row * D + c) = v[j] * rstd * *(const f32x4*)(p.final_g + c); } }
}
__device__ __forceinline__ void phase_readout(const Params& p, int j) {
    const int tid = fresh_tid(); const int lane = tid & 63, gw = blockIdx.x * 8 + (tid >> 6), nw = gridDim.x * 8;
    const bf16_t* O = (const bf16_t*)(p.ws + OFF_A); const bf16_t* SG = (const bf16_t*)(p.ws + OFF_BIG + 4 * T16); bf16_t* R = (bf16_t*)(p.ws + OFF_BIG);
    const float* gn = p.hg_gn + (size_t)j * 128 + (lane & 7) * 16;
    for (int row = gw; row < MTOK; row += nw) { const size_t off = (size_t)row * D + 16 * lane;
        const u32x4 o0 = *(const u32x4*)(O + off), o1 = *(const u32x4*)(O + off + 8), g0 = *(const u32x4*)(SG + off), g1 = *(const u32x4*)(SG + off + 8);
        float ov[16], gv[16];
#pragma unroll
        for (int e = 0; e < 4; ++e) { ov[2 * e] = bf_lo(o0[e]); ov[2 * e + 1] = bf_hi(o0[e]); ov[8 + 2 * e] = bf_lo(o1[e]); ov[9 + 2 * e] = bf_hi(o1[e]);
            gv[2 * e] = bf_lo(g0[e]); gv[2 * e + 1] = bf_hi(g0[e]); gv[8 + 2 * e] = bf_lo(g1[e]); gv[9 + 2 * e] = bf_hi(g1[e]); }
        float s = 0.f;
#pragma unroll
        for (int e = 0; e < 16; ++e) s += ov[e] * ov[e];
        s += __shfl_xor(s, 1); s += __shfl_xor(s, 2); s += __shfl_xor(s, 4);
        const float rstd = __builtin_amdgcn_rsqf(s * (1.0f / 128.0f) + 1e-6f); u32x4 w0, w1;
#pragma unroll
        for (int e = 0; e < 4; ++e) { w0[e] = pk_bf16(ov[2 * e] * rstd * gn[2 * e] * gv[2 * e], ov[2 * e + 1] * rstd * gn[2 * e + 1] * gv[2 * e + 1]);
            w1[e] = pk_bf16(ov[8 + 2 * e] * rstd * gn[8 + 2 * e] * gv[8 + 2 * e], ov[9 + 2 * e] * rstd * gn[9 + 2 * e] * gv[9 + 2 * e]); }
        *(u32x4*)(R + off) = w0; *(u32x4*)(R + off + 8) = w1; }
}
__device__ __forceinline__ void phase_mla_norm(const Params& p, int j) {
    const int tid = fresh_tid(); const int lane = tid & 63, gw = blockIdx.x * 8 + (tid >> 6), nw = gridDim.x * 8;
    const float* DP = (const float*)(p.ws + OFF_BIG); bf16_t* CQN = (bf16_t*)(p.ws + OFF_BIG + 106954752 + 2 * T16); bf16_t* CKVN = CQN + (size_t)MTOK * 384;
    const float* qn = p.mla_q_norm + (size_t)j * 384; const float* kn = p.mla_kv_norm + (size_t)j * 256;
    for (int row = gw; row < MTOK; row += nw) { const float* dp = DP + (size_t)row * 640;
        f32x2 a[3]; float s = 0.f;
#pragma unroll
        for (int t = 0; t < 3; ++t) { a[t] = *(const f32x2*)(dp + 2 * lane + 128 * t); s += a[t][0] * a[t][0] + a[t][1] * a[t][1]; }
        const f32x4 b = *(const f32x4*)(dp + 384 + 4 * lane); const float s2 = (b[0] * b[0] + b[1] * b[1]) + (b[2] * b[2] + b[3] * b[3]);
        const float r1 = __builtin_amdgcn_rsqf(wave_sum(s) * (1.0f / 384.0f) + 1e-6f), r2 = __builtin_amdgcn_rsqf(wave_sum(s2) * (1.0f / 256.0f) + 1e-6f);
#pragma unroll
        for (int t = 0; t < 3; ++t) { const int c = 2 * lane + 128 * t; *(unsigned*)(CQN + (size_t)row * 384 + c) = pk_bf16(a[t][0] * r1 * qn[c], a[t][1] * r1 * qn[c + 1]); }
        { const int c = 4 * lane; u32x2 w; w.x = pk_bf16(b[0] * r2 * kn[c], b[1] * r2 * kn[c + 1]); w.y = pk_bf16(b[2] * r2 * kn[c + 2], b[3] * r2 * kn[c + 3]); *(u32x2*)(CKVN + (size_t)row * 256 + c) = w; } }
}

__device__ __forceinline__ float dpp_xor1(float v) { return __int_as_float(__builtin_amdgcn_update_dpp(0, __float_as_int(v), 0xB1, 0xF, 0xF, true)); }
__device__ __forceinline__ float dpp_xor2(float v) { return __int_as_float(__builtin_amdgcn_update_dpp(0, __float_as_int(v), 0x4E, 0xF, 0xF, true)); }
__device__ __forceinline__ float dpp_hmir(float v) { return __int_as_float(__builtin_amdgcn_update_dpp(0, __float_as_int(v), 0x141, 0xF, 0xF, true)); }
constexpr int SNB = 272;
__device__ __forceinline__ int scan_block(int dir, int i) { return dir == 0 ? i : (i < 16 ? 15 - i : 287 - i); }
__device__ __forceinline__ int scan_row(int b, int X, int tt) { return X < 16 ? NLAT + b * CTXL + X * 16 + tt : b * SEQ + (X - 16) * 16 + tt; }
__device__ __forceinline__ void phase_scan(const Params& p, unsigned char* smem) {
    float* sF = (float*)smem;
    float* sQ = sF + 2 * 2 * 16 * 128;
    float* sV = sQ + 2 * 2 * 16 * 128;
    float* sVN = sV + 2 * 2 * 16 * 32;
    float* sPO = sVN + 3 * 2 * 16 * 32;
    float* sQS = sPO + 2 * 2 * 16 * 8 * 32;
    const u16* QH = (const u16*)(p.ws + OFF_BIG); const u16* FF = QH + T16 / 2; const u16* FB = FF + T16 / 2; const u16* VI = FB + T16 / 2; bf16_t* O = (bf16_t*)(p.ws + OFF_A);
    const int tid = fresh_tid(), wave = __builtin_amdgcn_readfirstlane(tid >> 6), lane = tid & 63;
    for (int task = blockIdx.x; task < 256; task += gridDim.x) {
        const int b = task >> 5, h = (task >> 2) & 7, vq = task & 3;
        if (wave < 4) {
            const int dir = wave >> 1, khalf = wave & 1, ksub = lane & 7, vg = lane >> 3, kbase = khalf * 64 + ksub * 8;
            f32x2 S2[8][2];
            { const u32x2 w0 = *(const u32x2*)(VI + (size_t)scan_row(b, scan_block(dir, 0), dir ? 15 : 0) * D + h * 128 + vq * 32 + 4 * vg);
              const f32x2 iA = {-bf_lo(w0.x), -bf_hi(w0.x)}, iB = {-bf_lo(w0.y), -bf_hi(w0.y)};
#pragma unroll
              for (int e = 0; e < 8; ++e) { S2[e][0] = iA; S2[e][1] = iB; } }
            __syncthreads();
            for (int it = 0; it < SNB; ++it) { const int buf = it & 1;
                const float* bF = sF + (buf * 2 + dir) * 16 * 128 + kbase; const float* bQ = sQ + (buf * 2 + dir) * 16 * 128 + kbase; const float* bV = sV + (buf * 2 + dir) * 16 * 32 + 4 * vg;
                float* bP = sPO + ((buf * 2 + dir) * 16 * 8 + khalf * 4 + (ksub >> 1)) * 32 + 4 * vg;
#define SC_LD(X, s_) do { const int tt_ = dir ? 15 - (s_) : (s_); X##f0 = *(const f32x4*)(bF + tt_ * 128); X##f1 = *(const f32x4*)(bF + tt_ * 128 + 4); \
                    X##q0 = *(const f32x4*)(bQ + tt_ * 128); X##q1 = *(const f32x4*)(bQ + tt_ * 128 + 4); X##vv = *(const f32x4*)(bV + tt_ * 32); } while (0)
#define SC_STEP(X, s_) do { const int tt_ = dir ? 15 - (s_) : (s_); f32x2 oA = {0.f, 0.f}, oB = {0.f, 0.f}; const f32x2 vA = {X##vv[0], X##vv[1]}, vB = {X##vv[2], X##vv[3]}; \
                    _Pragma("unroll") for (int k = 0; k < 8; ++k) { const float f = k < 4 ? X##f0[k & 3] : X##f1[k & 3], q = k < 4 ? X##q0[k & 3] : X##q1[k & 3]; const f32x2 fb = {f, f}, qb = {q, q}; \
                        S2[k][0] = __builtin_elementwise_fma(fb, S2[k][0], vA); S2[k][1] = __builtin_elementwise_fma(fb, S2[k][1], vB); \
                        oA = __builtin_elementwise_fma(S2[k][0], qb, oA); oB = __builtin_elementwise_fma(S2[k][1], qb, oB); } \
                    f32x4 o = {oA[0], oA[1], oB[0], oB[1]}; \
                    _Pragma("unroll") for (int e = 0; e < 4; ++e) { o[e] += dpp_xor1(o[e]); } \
                    *(f32x4*)(bP + tt_ * 256) = o; } while (0)
                f32x4 Af0, Af1, Aq0, Aq1, Avv, Bf0, Bf1, Bq0, Bq1, Bvv;
                SC_LD(A, 0);
#pragma unroll
                for (int s = 0; s < 16; s += 2) { SC_LD(B, s + 1); SC_STEP(A, s); SC_LD(A, (s + 2 < 16 ? s + 2 : 15)); SC_STEP(B, s + 1); }
#undef SC_LD
#undef SC_STEP
                __syncthreads();
            }
            __syncthreads();
        } else {
            const int ht = tid - 256, stt = ht >> 4, sc = ht & 15, vdir = ht >> 6, vtt = (ht & 63) >> 2, vc = ht & 3, ftt = ht >> 3, fv4 = ht & 7;
            u32x4 rf[2], rq[2], rv, rvn;
#define SC_GLOAD(it_) do { _Pragma("unroll") for (int d = 0; d < 2; ++d) { const size_t ro = (size_t)scan_row(b, scan_block(d, (it_)), stt) * D + h * 128 + 8 * sc; \
                rf[d] = *(const u32x4*)((d ? FB : FF) + ro); rq[d] = *(const u32x4*)(QH + ro); } \
                if (ht < 128) { rv = *(const u32x4*)(VI + (size_t)scan_row(b, scan_block(vdir, (it_)), vtt) * D + h * 128 + vq * 32 + 8 * vc); \
                    const int s_ = vdir ? 15 - vtt : vtt; const bool inblk = s_ < 15; const int nit = inblk ? (it_) : (it_) + 1; const int ntt = inblk ? (vdir ? vtt - 1 : vtt + 1) : (vdir ? 15 : 0); \
                    rvn = (u32x4){0u, 0u, 0u, 0u}; if (nit < SNB) rvn = *(const u32x4*)(VI + (size_t)scan_row(b, scan_block(vdir, nit), ntt) * D + h * 128 + vq * 32 + 8 * vc); } } while (0)
#define SC_LSTORE(buf_, ring_) do { _Pragma("unroll") for (int d = 0; d < 2; ++d) { float* fp = sF + (((buf_) * 2 + d) * 16 + stt) * 128 + 8 * sc; float* qp = sQ + (((buf_) * 2 + d) * 16 + stt) * 128 + 8 * sc; f32x4 a0, a1, b0, b1; \
                a0[0] = (float)(rf[d][0] & 0xffffu); a0[1] = (float)(rf[d][0] >> 16); a0[2] = (float)(rf[d][1] & 0xffffu); a0[3] = (float)(rf[d][1] >> 16); \
                a1[0] = (float)(rf[d][2] & 0xffffu); a1[1] = (float)(rf[d][2] >> 16); a1[2] = (float)(rf[d][3] & 0xffffu); a1[3] = (float)(rf[d][3] >> 16); \
                b0[0] = bf_lo(rq[d][0]); b0[1] = bf_hi(rq[d][0]); b0[2] = bf_lo(rq[d][1]); b0[3] = bf_hi(rq[d][1]); b1[0] = bf_lo(rq[d][2]); b1[1] = bf_hi(rq[d][2]); b1[2] = bf_lo(rq[d][3]); b1[3] = bf_hi(rq[d][3]); \
                *(f32x4*)fp = a0 * (1.0f / 65535.0f); *(f32x4*)(fp + 4) = a1 * (1.0f / 65535.0f); *(f32x4*)qp = b0; *(f32x4*)(qp + 4) = b1; \
                sQS[(((ring_) * 2 + d) * 16 + stt) * 16 + sc] = ((b0[0] + b0[1]) + (b0[2] + b0[3])) + ((b1[0] + b1[1]) + (b1[2] + b1[3])); } \
                if (ht < 128) { float* vp = sV + (((buf_) * 2 + vdir) * 16 + vtt) * 32 + 8 * vc; float* np = sVN + (((ring_) * 2 + vdir) * 16 + vtt) * 32 + 8 * vc; f32x4 c0, c1, n0, n1; \
                    c0[0] = bf_lo(rv[0]); c0[1] = bf_hi(rv[0]); c0[2] = bf_lo(rv[1]); c0[3] = bf_hi(rv[1]); c1[0] = bf_lo(rv[2]); c1[1] = bf_hi(rv[2]); c1[2] = bf_lo(rv[3]); c1[3] = bf_hi(rv[3]); \
                    n0[0] = bf_lo(rvn[0]); n0[1] = bf_hi(rvn[0]); n0[2] = bf_lo(rvn[1]); n0[3] = bf_hi(rvn[1]); n1[0] = bf_lo(rvn[2]); n1[1] = bf_hi(rvn[2]); n1[2] = bf_lo(rvn[3]); n1[3] = bf_hi(rvn[3]); \
                    *(f32x4*)vp = c0 - n0; *(f32x4*)(vp + 4) = c1 - n1; *(f32x4*)np = n0; *(f32x4*)(np + 4) = n1; } } while (0)
#define SC_FINAL(it_) do { if (ht < 128) { const int fb_ = (it_) & 1; u32x2 pv[2]; bf16_t* op[2]; bool rmw[2]; \
                _Pragma("unroll") for (int d = 0; d < 2; ++d) { const int X = scan_block(d, (it_)); const int other = d == 0 ? (X < 16 ? 15 - X : 287 - X) : X; rmw[d] = (it_) > other; \
                    op[d] = O + (size_t)scan_row(b, X, ftt) * D + h * 128 + vq * 32 + 4 * fv4; if (rmw[d]) pv[d] = *(const u32x2*)op[d]; } \
                _Pragma("unroll") for (int d = 0; d < 2; ++d) { const float* pp = sPO + ((fb_ * 2 + d) * 16 + ftt) * 256 + 4 * fv4; f32x4 o = ((*(const f32x4*)pp + *(const f32x4*)(pp + 32)) + (*(const f32x4*)(pp + 64) + *(const f32x4*)(pp + 96))) + ((*(const f32x4*)(pp + 128) + *(const f32x4*)(pp + 160)) + (*(const f32x4*)(pp + 192) + *(const f32x4*)(pp + 224))); \
                    { const int rg_ = (it_) % 3; const float* qsp = sQS + ((rg_ * 2 + d) * 16 + ftt) * 16; const f32x4 c4 = (*(const f32x4*)qsp + *(const f32x4*)(qsp + 4)) + (*(const f32x4*)(qsp + 8) + *(const f32x4*)(qsp + 12)); \
                      const float ct = (c4[0] + c4[1]) + (c4[2] + c4[3]); o = o + ct * *(const f32x4*)(sVN + ((rg_ * 2 + d) * 16 + ftt) * 32 + 4 * fv4); }     \
                    if (rmw[d]) { o[0] += bf_lo(pv[d].x); o[1] += bf_hi(pv[d].x); o[2] += bf_lo(pv[d].y); o[3] += bf_hi(pv[d].y); } \
                    u32x2 w; w.x = pk_bf16(o[0], o[1]); w.y = pk_bf16(o[2], o[3]); *(u32x2*)op[d] = w; } } } while (0)
            SC_GLOAD(0); SC_LSTORE(0, 0); SC_GLOAD(1);
            __syncthreads();
            for (int it = 0; it < SNB; ++it) {
                if (it + 1 < SNB) SC_LSTORE((it + 1) & 1, (it + 1) % 3);
                if (it + 2 < SNB) SC_GLOAD(it + 2);
                if (it > 0) SC_FINAL(it - 1);
                __syncthreads();
            }
            SC_FINAL(SNB - 1);
            __syncthreads();
#undef SC_GLOAD
#undef SC_LSTORE
#undef SC_FINAL
        }
    }
}

constexpr int KNROW = 256, KRROW = 128, VROW = 128, KNBUF = 64 * KNROW, KRBUF = 64 * KRROW, VBUF = 128 * VROW, ATT_STAGE = KNBUF + KRBUF + VBUF;
__device__ __forceinline__ void phase_attn(const Params& p, unsigned char* smem, bool with_ctx) {
    const bf16_t* QB = (const bf16_t*)(p.ws + OFF_BIG); const bf16_t* KN = QB + (size_t)MTOK * 1536; const bf16_t* VT = KN + (size_t)MTOK * D;
    const bf16_t* KR = VT + (size_t)MTOK * D + (size_t)MTOK * 384 + (size_t)MTOK * 256; bf16_t* AO = (bf16_t*)(p.ws + OFF_A);
    LAS unsigned char* lds = (LAS unsigned char*)smem;
    const int tid = fresh_tid(), wave = __builtin_amdgcn_readfirstlane(tid >> 6), lane = tid & 63, fr = lane & 15, fq = lane >> 4;
    const int nrounds = with_ctx ? 5 : 4; const int xcd = blockIdx.x & 7, jx = blockIdx.x >> 3;
    if (wave >= 4) __builtin_amdgcn_s_setprio(1);
    for (int rnd = 0; rnd < nrounds; ++rnd) {
        int b, head, qrow0, t0;
        if (rnd < 4) { const int grp = xcd * 8 + rnd * 2 + (jx >> 4); b = grp >> 3; head = grp & 7; qrow0 = b * SEQ + (jx & 15) * 256; t0 = 0; }
        else { if (blockIdx.x >= 64) break; b = blockIdx.x >> 3; head = blockIdx.x & 7; qrow0 = NLAT + b * CTXL; t0 = 64; }
        unsigned doff[5];
#pragma unroll
        for (int i = 0; i < 2; ++i) { const int ci = 64 * (wave + 8 * i) + lane, rho = ci >> 4, c = (ci & 15) ^ (rho & 15), ii = rho & 15, key = (rho & 32) + 8 * (ii >> 2) + 4 * ((rho >> 4) & 1) + (ii & 3);
            doff[i] = (unsigned)(key * D + head * 128 + 8 * c); }
        { const int ci = 64 * wave + lane, rho = ci >> 3, c = (ci & 7) ^ ((rho >> 1) & 7), ii = rho & 15, key = (rho & 32) + 8 * (ii >> 2) + 4 * ((rho >> 4) & 1) + (ii & 3); doff[2] = (unsigned)(key * 64 + 8 * c); }
#pragma unroll
        for (int i = 0; i < 2; ++i) { const int ci = 64 * (wave + 8 * i) + lane, vcol = ci >> 3, c = (ci & 7) ^ ((vcol >> 1) & 7); doff[3 + i] = (unsigned)((head * 128 + vcol) * MTOK + 8 * c); }
#define ATT_DMA(t, buf) do { const int tok0 = (t) < 64 ? b * SEQ + (t) * 64 : NLAT + b * CTXL + ((t) - 64) * 64; LAS unsigned char* st_ = lds + (buf) * ATT_STAGE; \
            __builtin_amdgcn_global_load_lds((const unsigned*)(KN + (size_t)tok0 * D + doff[0]), (LAS unsigned*)(st_ + wave * 1024), 16, 0, 0); \
            __builtin_amdgcn_global_load_lds((const unsigned*)(KN + (size_t)tok0 * D + doff[1]), (LAS unsigned*)(st_ + (wave + 8) * 1024), 16, 0, 0); \
            __builtin_amdgcn_global_load_lds((const unsigned*)(KR + (size_t)tok0 * 64 + doff[2]), (LAS unsigned*)(st_ + KNBUF + wave * 1024), 16, 0, 0); \
            __builtin_amdgcn_global_load_lds((const unsigned*)(VT + (size_t)tok0 + doff[3]), (LAS unsigned*)(st_ + KNBUF + KRBUF + wave * 1024), 16, 0, 0); \
            __builtin_amdgcn_global_load_lds((const unsigned*)(VT + (size_t)tok0 + doff[4]), (LAS unsigned*)(st_ + KNBUF + KRBUF + (wave + 8) * 1024), 16, 0, 0); } while (0)
        bf16x8 qf[2][6];
#pragma unroll
        for (int g = 0; g < 2; ++g)
#pragma unroll
            for (int kk = 0; kk < 6; ++kk) qf[g][kk] = *(const bf16x8*)(QB + (size_t)(qrow0 + wave * 32 + g * 16 + fr) * 1536 + head * 192 + kk * 32 + fq * 8);
        if (rnd < 4) {
            const float* rope = (const float*)(p.ws + OFF_ROPE);
#pragma unroll
            for (int g = 0; g < 2; ++g) { const int pos = (qrow0 + wave * 32 + g * 16 + fr) & 4095;
#pragma unroll
                for (int kk = 4; kk < 6; ++kk) { const int P = kk == 5 ? (pos & 63) : (pos >> 6); const float* cs = rope + (P * 16 + (fq & 1) * 8) * 2; const float sg = (fq & 2) ? 1.0f : -1.0f;
                    u32x4 mine = __builtin_bit_cast(u32x4, qf[g][kk]), res;
#pragma unroll
                    for (int e = 0; e < 4; ++e) { const unsigned pw = (unsigned)__shfl_xor((int)mine[e], 32); const f32x4 c4 = *(const f32x4*)(cs + 4 * e);
                        const float r0 = bf_lo(mine[e]) * c4[0] + sg * bf_lo(pw) * c4[1], r1 = bf_hi(mine[e]) * c4[2] + sg * bf_hi(pw) * c4[3]; res[e] = pk_bf16(r0, r1); }
                    qf[g][kk] = __builtin_bit_cast(bf16x8, res); } }
        }
        f32x4 o[2][8]; float mrow[2], lrow[2];
#pragma unroll
        for (int g = 0; g < 2; ++g) { mrow[g] = 0.f; lrow[g] = 0.f;
#pragma unroll
            for (int jb = 0; jb < 8; ++jb) o[g][jb] = (f32x4){0.f, 0.f, 0.f, 0.f}; }
        int okn[4], o8[2];
#pragma unroll
        for (int kk = 0; kk < 4; ++kk) okn[kk] = fr * KNROW + (((kk * 4 + fq) ^ fr) * 16);
#pragma unroll
        for (int j = 0; j < 2; ++j) o8[j] = fr * 128 + (((j * 4 + fq) ^ (fr >> 1)) * 16);
        ATT_DMA(t0, 0); asm volatile("s_waitcnt vmcnt(0)" ::: "memory"); __syncthreads();
        for (int t = t0; t < 68; ++t) { const int cur = (t - t0) & 1;
            if (t + 1 < 68) ATT_DMA(t + 1, cur ^ 1);
            const LAS unsigned char* kb = lds + cur * ATT_STAGE; const LAS unsigned char* rb = kb + KNBUF; const LAS unsigned char* vb = rb + KRBUF;
            f32x4 s[2][4];
            const f32x4 ci0 = {-mrow[0], -mrow[0], -mrow[0], -mrow[0]}, ci1 = {-mrow[1], -mrow[1], -mrow[1], -mrow[1]};
#pragma unroll
            for (int kt = 0; kt < 4; ++kt) { s[0][kt] = ci0; s[1][kt] = ci1;
#pragma unroll
                for (int kk = 0; kk < 6; ++kk) { const bf16x8 kf = kk < 4 ? *(const LAS bf16x8*)(kb + kt * 16 * KNROW + okn[kk & 3]) : *(const LAS bf16x8*)(rb + kt * 16 * KRROW + o8[kk & 1]);
                    s[0][kt] = __builtin_amdgcn_mfma_f32_16x16x32_bf16(kf, qf[0][kk], s[0][kt], 0, 0, 0);
                    s[1][kt] = __builtin_amdgcn_mfma_f32_16x16x32_bf16(kf, qf[1][kk], s[1][kt], 0, 0, 0); } }
            bf16x8 pf[2][2];
#pragma unroll
            for (int g = 0; g < 2; ++g) { float mx = -1e30f;
#pragma unroll
                for (int kt = 0; kt < 4; ++kt) mx = max3f(max3f(mx, s[g][kt][0], s[g][kt][1]), s[g][kt][2], s[g][kt][3]);
                mx = rows_max(mx);
                const bool grow = mx > 0.f; const float dlt = grow ? mx : 0.f, alpha = __builtin_amdgcn_exp2f(-dlt); mrow[g] += dlt; float ls = 0.f;
                if (__builtin_amdgcn_ballot_w64(grow) != 0ull) {
#pragma unroll
                    for (int kt = 0; kt < 4; ++kt) s[g][kt] = s[g][kt] - dlt;
#pragma unroll
                    for (int jb = 0; jb < 8; ++jb) o[g][jb] *= alpha; }
#pragma unroll
                for (int kt = 0; kt < 4; ++kt)
#pragma unroll
                    for (int e = 0; e < 4; ++e) { s[g][kt][e] = __builtin_amdgcn_exp2f(s[g][kt][e]); ls += s[g][kt][e]; }
                lrow[g] = lrow[g] * alpha + ls;
#pragma unroll
                for (int kg = 0; kg < 2; ++kg) { u32x4 w; w.x = pk_bf16(s[g][2 * kg][0], s[g][2 * kg][1]); w.y = pk_bf16(s[g][2 * kg][2], s[g][2 * kg][3]);
                    w.z = pk_bf16(s[g][2 * kg + 1][0], s[g][2 * kg + 1][1]); w.w = pk_bf16(s[g][2 * kg + 1][2], s[g][2 * kg + 1][3]); pf[g][kg] = __builtin_bit_cast(bf16x8, w); } }
#pragma unroll
            for (int kg = 0; kg < 2; ++kg)
#pragma unroll
                for (int jb = 0; jb < 8; ++jb) { const bf16x8 vf = *(const LAS bf16x8*)(vb + jb * 16 * VROW + o8[kg]);
                    o[0][jb] = __builtin_amdgcn_mfma_f32_16x16x32_bf16(vf, pf[0][kg], o[0][jb], 0, 0, 0);
                    o[1][jb] = __builtin_amdgcn_mfma_f32_16x16x32_bf16(vf, pf[1][kg], o[1][jb], 0, 0, 0); }
            asm volatile("s_waitcnt vmcnt(0)" ::: "memory");
            __syncthreads();
        }
#undef ATT_DMA
#pragma unroll
        for (int g = 0; g < 2; ++g) { float lt = lrow[g]; lt += __shfl_xor(lt, 16); lt += __shfl_xor(lt, 32); const float inv = 1.0f / lt;
            bf16_t* op = AO + (size_t)(qrow0 + wave * 32 + g * 16 + fr) * D + head * 128 + 4 * fq;
#pragma unroll
            for (int jb = 0; jb < 8; ++jb) { const f32x4 v = o[g][jb] * inv; u32x2 w; w.x = pk_bf16(v[0], v[1]); w.y = pk_bf16(v[2], v[3]); *(u32x2*)(op + jb * 16) = w; } }
        __syncthreads();
    }
    __builtin_amdgcn_s_setprio(0);
}

__global__ void __launch_bounds__(512) fwd_megakernel(Params p) {
    extern __shared__ __attribute__((aligned(16))) unsigned char smem[];
    cg::grid_group grid = cg::this_grid();
    LAS unsigned char* lds = (LAS unsigned char*)smem;
    bf16_t* W = (bf16_t*)(p.ws + OFF_W); float* H = (float*)(p.ws + OFF_H); bf16_t* A = (bf16_t*)(p.ws + OFF_A); unsigned char* BIG = p.ws + OFF_BIG;
    float* PFFN = (float*)(BIG + 209715200); float* PHG = (float*)(BIG + T16); float* PMLA = (float*)(BIG + 314572800);
    const float* modall = (const float*)(p.ws + OFF_MOD); const float* rope = (const float*)(p.ws + OFF_ROPE);
    volatile LAS unsigned* xst = (volatile LAS unsigned*)(lds + LDS_MAIN);
    if (threadIdx.x < 4) xst[threadIdx.x] = 0u;
    __syncthreads();
    XcdBarrier xbar = xcd_barrier_post((unsigned*)(p.ws + OFF_BAR), xst);
    phase_prologue(p, smem, 0, 1, 0, true);
    convert_layer(p, smem, 0);
    grid.sync();
#define GRID_BAR() xcd_barrier(xbar)
#define RESID_NORM(KT, Aop, Wop, midx, coef, from_in, Pbuf, nlayer, gi, mbase, ctx_in, EXTRA_Y, EXTRA) do { \
        resid_latent<KT>(lds, p, Aop, Wop, H, modl, midx, coef, from_in); GRID_BAR(); \
        if (blockIdx.x < 32) resid_ctx<KT>(lds, Aop, Wop, Pbuf); else { phase_norm(p, nlayer, gi, mbase, 0, nullptr, 0, 0, 0.f, 0, 0, NLAT, 32); EXTRA_Y; } \
        GRID_BAR(); \
        phase_norm(p, nlayer, gi, mbase, 0, Pbuf, layer, midx, coef, ctx_in, NLAT, MTOK, 0); EXTRA; GRID_BAR(); } while (0)
    phase_norm(p, 0, 0, 0, 1, nullptr, 0, 0, 0.f, 0, 0, MTOK, 0);
    GRID_BAR();
    for (int layer = 0; layer < 4; ++layer) {
        const float* modl = modall + (size_t)layer * 9 * (NMOD * D); const int j = layer >> 1;
        { EpiGateUp e; e.hid = (bf16_t*)BIG; run_gemm(lds, A, W + W_GU0, MTOK, 2 * FH, D, e); }
        GRID_BAR();
        if (layer == 0) RESID_NORM(FH, (const bf16_t*)BIG, W + W_D0, 2, 0.5f, 1, PFFN, 0, 1, 3, 1, phase_prologue(p, smem, 1, 4, 32, false), (void)0);
        else RESID_NORM(FH, (const bf16_t*)BIG, W + W_D0, 2, 0.5f, 0, PFFN, layer, 1, 3, 0, (void)0, (void)0);
        if ((layer & 1) == 0) {
            { EpiHgIn e; e.base = (u16*)BIG; e.lb = (const float*)(p.ws + OFF_LB) + j * 2048; run_gemm(lds, A, W + W_IN, MTOK, 5120, D, e); }
            GRID_BAR();
            phase_scan(p, smem);
            GRID_BAR();
            phase_readout(p, j);
            GRID_BAR();
            RESID_NORM(D, (const bf16_t*)BIG, W + W_OUT, 5, 1.0f, 0, PHG, layer, 2, 6, 0, (void)0, (void)0);
        } else {
            bf16_t* QB = (bf16_t*)BIG; bf16_t* KN = QB + (size_t)MTOK * 1536; bf16_t* VT = KN + (size_t)MTOK * D; bf16_t* CQN = VT + (size_t)MTOK * D; bf16_t* CKVN = CQN + (size_t)MTOK * 384; bf16_t* KR = CKVN + (size_t)MTOK * 256;
            { EpiMlaDown e; e.dproj = (float*)BIG; e.kr = KR; e.rope = rope; run_gemm(lds, A, W + W_DN, MTOK, 768, D, e); }
            GRID_BAR();
            phase_mla_norm(p, j);
            GRID_BAR();
            { EpiBf16 e; e.o = QB; e.ldc = 1536; e.scale = QSCALE; run_gemm(lds, CQN, W + W_UQ, layer == 3 ? NLAT : MTOK, 1536, 384, e); }
            { EpiBf16 e; e.o = KN; e.ldc = D; e.scale = 1.0f; run_gemm(lds, CKVN, W + W_K, MTOK, D, 256, e); }
            { EpiBf16 e; e.o = VT; e.ldc = MTOK; e.scale = 1.0f; run_gemm(lds, W + W_V, CKVN, D, MTOK, 256, e); }
            GRID_BAR();
            phase_attn(p, smem, layer != 3);
            GRID_BAR();
            if (layer != 3) RESID_NORM(D, A, W + W_O, 5, 1.0f, 0, PMLA, layer, 2, 6, 0, (void)0, (void)0);
            else { resid_latent<D>(lds, p, A, W + W_O, H, modl, 5, 1.0f, 0); GRID_BAR(); phase_norm(p, layer, 2, 6, 0, nullptr, 0, 0, 0.f, 0, 0, MTOK, 0); GRID_BAR(); }
        }
        { EpiGateUp e; e.hid = (bf16_t*)BIG; run_gemm(lds, A, W + W_GU1, layer == 3 ? NLAT : MTOK, 2 * FH, D, e); }
        GRID_BAR();
        if (layer != 3) RESID_NORM(FH, (const bf16_t*)BIG, W + W_D1, 8, 0.5f, 0, PFFN, layer + 1, 0, 0, 0, convert_layer(p, smem, layer + 1, 1, 32), convert_layer(p, smem, layer + 1, 2, 0));
        else { resid_latent<FH>(lds, p, (const bf16_t*)BIG, W + W_D1, H, modl, 8, 0.5f, 0); GRID_BAR(); }
    }
    phase_final(p);
}

extern "C" void kernel_launch(void* const* d_in, const int* in_sizes, int n_in, void* d_out, int out_size, void* d_ws, size_t ws_size, hipStream_t stream) {
    static int grid_blocks = 0;
    if (grid_blocks == 0) {
        if (n_in != 21 || out_size != NLAT * D || ws_size < WS_END) { fprintf(stderr, "kernel_launch: unexpected shapes (n_in %d out %d ws %zu need %zu)\n", n_in, out_size, ws_size, (size_t)WS_END); grid_blocks = -1; return; }
        int dev = 0, cus = 0, per_cu = 0;
        hipGetDevice(&dev); hipDeviceGetAttribute(&cus, hipDeviceAttributeMultiprocessorCount, dev);
        if (hipFuncSetAttribute((const void*)fwd_megakernel, hipFuncAttributeMaxDynamicSharedMemorySize, LDS_BYTES) != hipSuccess) { fprintf(stderr, "kernel_launch: hipFuncSetAttribute failed\n"); grid_blocks = -1; return; }
        hipOccupancyMaxActiveBlocksPerMultiprocessor(&per_cu, (const void*)fwd_megakernel, 512, LDS_BYTES);
        if (per_cu < 1) { fprintf(stderr, "kernel_launch: occupancy query says %d blocks per CU\n", per_cu); per_cu = 1; }
        (void)hipGetLastError();
        grid_blocks = cus;
    }
    if (grid_blocks < 0) return;
    if (hipMemsetAsync((unsigned char*)d_ws + OFF_BAR, 0, XCD_BAR_WORDS * 4, stream) != hipSuccess) { fprintf(stderr, "kernel_launch: memset failed\n"); return; }
    Params p{};
    const float** pp = (const float**)&p;
    for (int i = 0; i < 21; ++i) pp[i] = (const float*)d_in[i];
    p.out = (float*)d_out; p.ws = (unsigned char*)d_ws;
    void* args[] = {&p};
    hipError_t e = hipLaunchCooperativeKernel((const void*)fwd_megakernel, dim3(grid_blocks), dim3(512), args, LDS_BYTES, stream);
    if (e != hipSuccess) fprintf(stderr, "cooperative launch failed: %s (grid %d)\n", hipGetErrorString(e), grid_blocks);
}
```

```cpp
#include <hip/hip_runtime.h>
#include <hip/hip_cooperative_groups.h>
#include <cstdio>
namespace cg = cooperative_groups;
namespace pg8 {
#define PG8_LAS __attribute__((address_space(3)))
typedef unsigned short bf16_t;
typedef short bf16x8 __attribute__((ext_vector_type(8)));
typedef float f32x4 __attribute__((ext_vector_type(4)));
typedef unsigned u32x4 __attribute__((ext_vector_type(4)));
constexpr int BM = 256, BK = 64, HALF = 128, HTB = HALF * BK * 2  , STAGE_BYTES = 8 * HTB, NXCD = 8, WGM = 8;

__host__ __device__ __forceinline__ int lds_byte(int r, int c) { const int st = (r >> 4) * 2 + (c >> 5), rr = r & 15, cc = c & 31, ob = rr * 64 + cc * 2; return st * 1024 + (ob ^ (((ob >> 9) & 1) << 5)); }
__host__ __device__ __forceinline__ void stage_rc(int b, int& R, int& C) { const int st = b / 1024, sb = b % 1024, swz = sb ^ (((sb >> 9) & 1) << 5); R = (st >> 1) * 16 + swz / 64; C = (st & 1) * 32 + (swz % 64) / 2; }
__host__ __device__ __forceinline__ int perm32(int rho) { const int n = rho >> 4, i = rho & 15; return 8 * (i >> 2) + 4 * n + (i & 3); }

struct Unit { int pm, pn; };
struct Gemm { const bf16_t* A; const bf16_t* Bt; int M, N, K, ld; };

struct StaticOrder {
    int nM, nN, nwg, G, c;
    __host__ __device__ void init(int M, int N, int G_, int c_) { nM = M / BM; nN = N / BM; nwg = nM * nN; G = G_; c = c_; }
    __host__ __device__ bool next(int i, Unit& u) const {
        const long L = (long)i * G + c; if (L >= nwg) return false;
        int wgid = (int)L; { const int q = nwg / NXCD, r = nwg % NXCD, xcd = wgid % NXCD, off = wgid / NXCD; wgid = (xcd < r ? xcd * (q + 1) : r * (q + 1) + (xcd - r) * q) + off; }
        const int nig = WGM * nN, gid = wgid / nig, fm = gid * WGM, gsz = (nM - fm) < WGM ? (nM - fm) : WGM;
        u.pm = fm + ((wgid % nig) % gsz); u.pn = (wgid % nig) / gsz; return true;
    }
    __device__ __forceinline__ void a_ready(const Unit&) const {}
    __device__ __forceinline__ void done(const Unit&) const {}
};
__device__ __forceinline__ unsigned cvt_pk_bf16(float lo, float hi) { unsigned r; asm volatile("v_cvt_pk_bf16_f32 %0, %1, %2" : "=v"(r) : "v"(lo), "v"(hi)); return r; }
typedef float f32x2 __attribute__((ext_vector_type(2)));
template <class Epi, class Sched, bool STAMP = false>
__device__ __forceinline__ void gemm_phase(PG8_LAS unsigned char* lds, const Gemm g, const Sched& S, const Epi& E, unsigned long long* stamps) {
    int tid_ = threadIdx.x; asm volatile("" : "+v"(tid_)); const int tid = tid_, wid = __builtin_amdgcn_readfirstlane(tid >> 6), lane = tid & 63, wr = wid >> 2, wc = wid & 3, fr = lane & 15, fq = lane >> 4;
    const int K = g.K, nt = K / BK, LD = g.ld;
    int ts_lo = 0, ts_hi = 0, nts = 0; const unsigned long long rt_entry = STAMP ? (unsigned long long)wall_clock64() : 0ull;
#define PG8_STAMP() do { if (STAMP && wid == 0 && nts < 64) { const unsigned long long _c = (unsigned long long)clock64(); \
        ts_lo = (lane == nts) ? (int)(unsigned)_c : ts_lo; ts_hi = (lane == nts) ? (int)(unsigned)(_c >> 32) : ts_hi; ++nts; } } while (0)
    PG8_STAMP();
    unsigned voffA[2], voffB[2];
#pragma unroll
    for (int i = 0; i < 2; ++i) { int R, C; stage_rc(tid * 16 + i * 8192, R, C); const int Rb = Epi::PERM ? ((R & ~31) + perm32(R & 31)) : R;
        voffA[i] = (unsigned)(R * LD + C) * 2u; voffB[i] = (unsigned)(Rb * LD + C) * 2u; }
    const size_t kstep = (size_t)(BK * 2);
    const size_t hstep = (size_t)HALF * LD * 2;
    const size_t tstep = 2 * hstep;
    const unsigned ldsw = (unsigned)wid * 1024u;
    const int aoff = lds_byte(wr * 64 + fr, fq * 8), boff = lds_byte(wc * 32 + fr, fq * 8);
#define PG8_SA(b, h) (((b) * 2 + (h)) * HTB)
#define PG8_SB(b, h) ((4 + (b) * 2 + (h)) * HTB)
#define PG8_STAGE(bufoff, gbase, voff) do { _Pragma("unroll") for (int _i = 0; _i < 2; ++_i) \
        __builtin_amdgcn_global_load_lds((const unsigned*)((const char*)(gbase) + (voff)[_i]), (PG8_LAS unsigned*)(lds + (bufoff) + ldsw + _i * 8192), 16, 0, 0); } while (0)
#define PG8_LDA(dst, b, h) do { _Pragma("unroll") for (int m = 0; m < 4; ++m) _Pragma("unroll") for (int k = 0; k < 2; ++k) dst[m][k] = *(const PG8_LAS bf16x8*)(lds + PG8_SA(b, h) + aoff + m * 2048 + k * 1024); } while (0)
#define PG8_LDB(dst, b, h) do { _Pragma("unroll") for (int n = 0; n < 2; ++n) _Pragma("unroll") for (int k = 0; k < 2; ++k) dst[n][k] = *(const PG8_LAS bf16x8*)(lds + PG8_SB(b, h) + boff + n * 2048 + k * 1024); } while (0)
#define PG8_MMA(ai, bj, At, Bt) do { __builtin_amdgcn_s_setprio(1); _Pragma("unroll") for (int m = 0; m < 4; ++m) _Pragma("unroll") for (int n = 0; n < 2; ++n) _Pragma("unroll") for (int k = 0; k < 2; ++k) \
        acc[ai][bj][m][n] = __builtin_amdgcn_mfma_f32_16x16x32_bf16(Bt[n][k], At[m][k], acc[ai][bj][m][n], 0, 0, 0); __builtin_amdgcn_s_setprio(0); } while (0)
#define PG8_WAIT_V(n) asm volatile("s_waitcnt vmcnt(" #n ")" ::: "memory")
#define PG8_WAIT_L(n) asm volatile("s_waitcnt lgkmcnt(" #n ")" ::: "memory")
#define PG8_BAR __builtin_amdgcn_s_barrier()
#define PG8_SCHED __builtin_amdgcn_sched_barrier(0)
    Unit cur, nxt; int ui = 0;
    if (!S.next(0, cur)) return;
    f32x4 acc[2][2][4][2];
#pragma unroll
    for (int a = 0; a < 2; ++a)
#pragma unroll
        for (int b = 0; b < 2; ++b)
#pragma unroll
            for (int m = 0; m < 4; ++m)
#pragma unroll
                for (int n = 0; n < 2; ++n) acc[a][b][m][n] = (f32x4){0.f, 0.f, 0.f, 0.f};
    bf16x8 At[4][2], B0[2][2], B1[2][2];
    const char* cA = (const char*)g.A + (size_t)cur.pm * tstep; const char* cB = (const char*)g.Bt + (size_t)cur.pn * tstep;
    S.a_ready(cur);
    PG8_STAGE(PG8_SB(0, 0), cB, voffB); PG8_STAGE(PG8_SA(0, 0), cA, voffA); PG8_STAGE(PG8_SB(0, 1), cB + hstep, voffB); PG8_STAGE(PG8_SA(0, 1), cA + hstep, voffA);
    if (wr == 1) PG8_BAR;
    PG8_WAIT_V(4); PG8_BAR;
    PG8_STAGE(PG8_SB(1, 0), cB + kstep, voffB); PG8_STAGE(PG8_SA(1, 0), cA + kstep, voffA); PG8_STAGE(PG8_SB(1, 1), cB + hstep + kstep, voffB);
    PG8_WAIT_V(6); PG8_BAR;
    PG8_STAMP();
    for (;;) {
        const bool has_next = S.next(ui + 1, nxt);
        const char* nA = has_next ? (const char*)g.A + (size_t)nxt.pm * tstep : cA; const char* nB = has_next ? (const char*)g.Bt + (size_t)nxt.pn * tstep : cB;
        for (int t = 0; t < nt; t += 2) {
            const bool last = (t == nt - 2);
            const char* a1 = cA + (size_t)(t + 1) * kstep;
            const char* a2 = last ? nA : cA + (size_t)(t + 2) * kstep; const char* b2 = last ? nB : cB + (size_t)(t + 2) * kstep;
            const char* a3 = a2 + kstep; const char* b3 = b2 + kstep;
            if (last && has_next) S.a_ready(nxt);
            PG8_LDB(B0, 0, 0); PG8_SCHED; PG8_LDA(At, 0, 0); PG8_STAGE(PG8_SA(1, 1), a1 + hstep, voffA);
            PG8_WAIT_L(8); PG8_BAR; PG8_WAIT_L(0); PG8_MMA(0, 0, At, B0); PG8_BAR; PG8_SCHED;
            PG8_LDB(B1, 0, 1); PG8_STAGE(PG8_SB(0, 0), b2, voffB);
            PG8_BAR; PG8_WAIT_L(0); PG8_MMA(0, 1, At, B1); PG8_BAR;
            PG8_LDA(At, 0, 1); PG8_STAGE(PG8_SA(0, 0), a2, voffA);
            PG8_BAR; PG8_WAIT_L(0); PG8_MMA(1, 0, At, B0); PG8_BAR; PG8_SCHED;
            PG8_STAGE(PG8_SB(0, 1), b2 + hstep, voffB);
            PG8_WAIT_V(6); PG8_BAR; PG8_MMA(1, 1, At, B1); PG8_BAR;
            PG8_LDB(B0, 1, 0); PG8_SCHED; PG8_LDA(At, 1, 0); PG8_STAGE(PG8_SA(0, 1), a2 + hstep, voffA);
            PG8_WAIT_L(8); PG8_BAR; PG8_WAIT_L(0); PG8_MMA(0, 0, At, B0); PG8_BAR; PG8_SCHED;
            PG8_LDB(B1, 1, 1); PG8_STAGE(PG8_SB(1, 0), b3, voffB);
            PG8_BAR; PG8_WAIT_L(0); PG8_MMA(0, 1, At, B1); PG8_BAR;
            PG8_LDA(At, 1, 1); PG8_STAGE(PG8_SA(1, 0), a3, voffA);
            PG8_BAR; PG8_WAIT_L(0); PG8_MMA(1, 0, At, B0); PG8_BAR; PG8_SCHED;
            PG8_STAGE(PG8_SB(1, 1), b3 + hstep, voffB);
            PG8_WAIT_V(6); PG8_BAR; PG8_MMA(1, 1, At, B1); PG8_BAR;
        }
        PG8_STAMP();
        if constexpr (!Epi::AFTER_DRAIN) { E(acc, cur, wr, wc, fr, fq); S.done(cur); }
        PG8_STAMP();
        if (!has_next) break;
#pragma unroll
        for (int a = 0; a < 2; ++a)
#pragma unroll
            for (int b = 0; b < 2; ++b)
#pragma unroll
                for (int m = 0; m < 4; ++m)
#pragma unroll
                    for (int n = 0; n < 2; ++n) acc[a][b][m][n] = (f32x4){0.f, 0.f, 0.f, 0.f};
        cur = nxt; cA = nA; cB = nB; ++ui;
    }
    PG8_WAIT_V(0);
    if (wr == 0) PG8_BAR;
    PG8_BAR;
    if constexpr (Epi::AFTER_DRAIN) { E.fused(acc, cur, wr, wc, fr, fq, lds, wid, lane); S.done(cur); }
    PG8_STAMP();
    if (STAMP && wid == 0) { stamps[lane] = lane < nts ? (((unsigned long long)(unsigned)ts_hi << 32) | (unsigned)ts_lo) : 0ull;
        if (lane == 62) stamps[62] = rt_entry; if (lane == 63) stamps[63] = (unsigned long long)wall_clock64(); }
#undef PG8_STAMP
#undef PG8_SA
#undef PG8_SB
#undef PG8_STAGE
#undef PG8_LDA
#undef PG8_LDB
#undef PG8_MMA
#undef PG8_WAIT_V
#undef PG8_WAIT_L
#undef PG8_BAR
#undef PG8_SCHED
}
}

typedef pg8::bf16_t bf16_t;
typedef pg8::bf16x8 bf16x8;
typedef pg8::f32x4 f32x4;
typedef unsigned short u16;
typedef unsigned u32x2 __attribute__((ext_vector_type(2)));
typedef unsigned u32x4 __attribute__((ext_vector_type(4)));
typedef float f32x2 __attribute__((ext_vector_type(2)));
#define LAS __attribute__((address_space(3)))

constexpr int D = 1024, NLAT = 32768, NCTX = 2048, MTOK = 34816, SEQ = 4096, CTXL = 256, FH = 2816, NMOD = 9;
constexpr int LDS_MAIN = 157696, LDS_BYTES = LDS_MAIN + 16;
constexpr size_t OFF_MOD = 4096, OFF_LB = 1331200, OFF_ROPE = 1347584, OFF_BAR = 1355776, OFF_W = 2097152, OFF_H = 50331648, OFF_A = 192937984, OFF_BIG = 264241152;
constexpr size_t T16 = 71303168;
constexpr size_t WS_END = OFF_BIG + 5 * T16;
constexpr size_t W_GU0 = 0, W_D0 = 5767168, W_GU1 = 8650752, W_D1 = 14417920, W_MIX = 17301504;
constexpr size_t W_IN = W_MIX, W_OUT = W_MIX + 5242880;
constexpr size_t W_DN = W_MIX, W_UQ = W_MIX + 786432, W_K = W_MIX + 1376256, W_V = W_MIX + 1638400, W_O = W_MIX + 1900544;
constexpr float QSCALE = 0.07216878364870322f * 1.4426950408889634f;

struct Params {
    const float *x, *c, *ctx, *c_ctx, *mod_w, *mod_b, *norm_g, *w_gate, *w_up, *w_down, *hg_w_in, *hg_w_out, *hg_gn, *hg_lb, *mla_w_down, *mla_q_norm, *mla_w_uq, *mla_kv_norm, *mla_w_ukv, *mla_w_o, *final_g;
    float* out; unsigned char* ws;
};

__device__ __forceinline__ int fresh_tid() { int t = threadIdx.x; asm volatile("" : "+v"(t)); return t; }
__device__ __forceinline__ unsigned pk_bf16(float lo, float hi) { unsigned r; asm volatile("v_cvt_pk_bf16_f32 %0, %1, %2" : "=v"(r) : "v"(lo), "v"(hi)); return r; }
__device__ __forceinline__ float bf_lo(unsigned w) { return __uint_as_float(w << 16); }
__device__ __forceinline__ float bf_hi(unsigned w) { return __uint_as_float(w & 0xffff0000u); }
__device__ __forceinline__ float sigmoidf_(float x) { return __builtin_amdgcn_rcpf(1.0f + __expf(-x)); }
__device__ __forceinline__ float siluf_(float x) { return x * sigmoidf_(x); }
__device__ __forceinline__ float rows_max(float v) {
    u32x2 a = __builtin_amdgcn_permlane32_swap(__float_as_uint(v), __float_as_uint(v), false, false); v = fmaxf(__uint_as_float(a.x), __uint_as_float(a.y));
    u32x2 b = __builtin_amdgcn_permlane16_swap(__float_as_uint(v), __float_as_uint(v), false, false); return fmaxf(__uint_as_float(b.x), __uint_as_float(b.y)); }
__device__ __forceinline__ float max3f(float a, float b, float c) { float r; asm("v_max3_f32 %0, %1, %2, %3" : "=v"(r) : "v"(a), "v"(b), "v"(c)); return r; }
__device__ __forceinline__ float wave_sum(float v) {
#pragma unroll
    for (int o = 1; o < 64; o <<= 1) v += __shfl_xor(v, o);
    return v;
}
__device__ __forceinline__ const float* in_row(const Params& p, int row) { return row < NLAT ? p.x + (size_t)row * D : p.ctx + (size_t)(row - NLAT) * D; }
__device__ __forceinline__ int mod_row(int row) { return row < NLAT ? (row >> 12) : 8; }


#define XB_TMO      128
#define XB_XCNT(j)  (256  + 64 * (j))
#define XB_XSUB(j)  (1280 + 64 * (j))
#define XB_XGEN(j)  (2304 + 64 * (j))
#define XB_TOP      3328
#define XB_TOPGEN   3392
#define XCD_BAR_WORDS 3456
#define XB_SPIN_CAP (1u << 22)
__device__ __forceinline__ unsigned xb_ld(unsigned* p)              { return __hip_atomic_load(p, __ATOMIC_RELAXED, __HIP_MEMORY_SCOPE_AGENT); }
__device__ __forceinline__ unsigned xb_add(unsigned* p, unsigned v) { return __hip_atomic_fetch_add(p, v, __ATOMIC_RELAXED, __HIP_MEMORY_SCOPE_AGENT); }
__device__ __forceinline__ unsigned xb_xcc_id() { return (unsigned)__builtin_amdgcn_s_getreg((3 << 11) | 20) & 0xFu; }
#define XB_SPIN(cond, bar) do { unsigned _sp = 0; while (cond) { __builtin_amdgcn_s_sleep(1); \
    if ((++_sp & 255u) == 0u) { if (xb_ld(&(bar)[XB_TMO])) break; if (_sp > XB_SPIN_CAP) { atomicAdd(&(bar)[XB_TMO], 1u); break; } } } } while (0)
struct XcdBarrier { unsigned* bar; unsigned x; volatile LAS unsigned* st; };
__device__ __forceinline__ XcdBarrier xcd_barrier_post(unsigned* bar, volatile LAS unsigned* st) {
    XcdBarrier b; b.bar = bar; b.x = xb_xcc_id(); b.st = st;
    if (threadIdx.x == 0) (void)xb_add(&bar[XB_XCNT(b.x)], 1u);
    return b;
}
__device__ __forceinline__ void xcd_barrier_complete(unsigned* bar, unsigned x, unsigned& nloc, unsigned& nx) {
    const unsigned G = gridDim.x * gridDim.y * gridDim.z;
    unsigned sum, cnt, mine, sp = 0u;
    for (;;) {
        sum = 0u; cnt = 0u; mine = 0u;
#pragma unroll
        for (unsigned j = 0; j < 16; ++j) { const unsigned c = xb_ld(&bar[XB_XCNT(j)]); sum += c; cnt += (c > 0u) ? 1u : 0u; mine = (j == x) ? c : mine; }
        if (sum == G) break;
        __builtin_amdgcn_s_sleep(1);
        if ((++sp & 255u) == 0u) { if (xb_ld(&bar[XB_TMO])) break; if (sp > XB_SPIN_CAP) { atomicAdd(&bar[XB_TMO], 1u); break; } }
    }
    nloc = mine > 0u ? mine : 1u; nx = cnt > 0u ? cnt : 1u;
}
__device__ __forceinline__ void xcd_barrier(const XcdBarrier& b) {
    asm volatile("s_waitcnt vmcnt(0)" ::: "memory");
    __syncthreads();
    if (threadIdx.x == 0) {
        unsigned* bar = b.bar;
        __builtin_amdgcn_s_waitcnt(0);
        unsigned nloc = b.st[0], nx = b.st[1];
        if (nloc == 0u) { xcd_barrier_complete(bar, b.x, nloc, nx); b.st[0] = nloc; b.st[1] = nx; }
        const unsigned old = xb_add(&bar[XB_XSUB(b.x)], 1u);
        const unsigned gen = old / nloc;
        if (old + 1u == (gen + 1u) * nloc) {
            __builtin_amdgcn_fence(__ATOMIC_RELEASE, "agent");
            asm volatile("s_waitcnt vmcnt(0)" ::: "memory");
            const unsigned og = xb_add(&bar[XB_TOP], 1u);
            const unsigned tg = og / nx;
            if (og + 1u == (tg + 1u) * nx) xb_add(&bar[XB_TOPGEN], 1u);
            else XB_SPIN(xb_ld(&bar[XB_TOPGEN]) == tg, bar);
            __builtin_amdgcn_fence(__ATOMIC_ACQUIRE, "agent");
            xb_add(&bar[XB_XGEN(b.x)], 1u);
            asm volatile("s_waitcnt vmcnt(0)" ::: "memory");
        } else {
            XB_SPIN(xb_ld(&bar[XB_XGEN(b.x)]) == gen, bar);
            __builtin_amdgcn_fence(__ATOMIC_ACQUIRE, "agent");
            asm volatile("s_waitcnt vmcnt(0)" ::: "memory");
        }
    }
    __syncthreads();
}

#define EPI_ARGS const f32x4 (&acc)[2][2][4][2], const pg8::Unit& u, int wr, int wc, int fr, int fq
struct EpiGateUp {
    static constexpr bool PERM = false, AFTER_DRAIN = false; bf16_t* hid;
    __device__ __forceinline__ void operator()(EPI_ARGS) const {
        const int row0 = u.pm * 256 + wr * 64 + fr, hc0 = u.pn * 128 + wc * 16 + 4 * fq;
#pragma unroll
        for (int ai = 0; ai < 2; ++ai)
#pragma unroll
            for (int m = 0; m < 4; ++m) { bf16_t* rp = hid + (size_t)(row0 + ai * 128 + m * 16) * FH + hc0;
#pragma unroll
                for (int bj = 0; bj < 2; ++bj) { const f32x4 g = acc[ai][bj][m][0], up = acc[ai][bj][m][1];
                    u32x2 w; w.x = pk_bf16(siluf_(g[0]) * up[0], siluf_(g[1]) * up[1]); w.y = pk_bf16(siluf_(g[2]) * up[2], siluf_(g[3]) * up[3]);
                    *(u32x2*)(rp + bj * 64) = w; } }
    }
};
struct EpiResid {
    static constexpr bool PERM = false, AFTER_DRAIN = false; const float* x; const float* ctx; float* H; const float* modl; int midx; float coef; int from_input; int row_off;
    __device__ __forceinline__ void operator()(EPI_ARGS) const {
        const int row0 = u.pm * 256 + wr * 64 + fr, col0 = u.pn * 256 + wc * 32 + 4 * fq;
        const float* mv = modl + (size_t)mod_row(u.pm * 256) * (NMOD * D) + midx * D + col0;
        f32x4 mm[2][2];
#pragma unroll
        for (int bj = 0; bj < 2; ++bj)
#pragma unroll
            for (int n = 0; n < 2; ++n) mm[bj][n] = *(const f32x4*)(mv + bj * 128 + n * 16) * coef;
#pragma unroll
        for (int ai = 0; ai < 2; ++ai)
#pragma unroll
            for (int m = 0; m < 4; ++m) { const int row = row0 + ai * 128 + m * 16;
                const float* sp = (from_input ? (row < NLAT ? x + (size_t)row * D : ctx + (size_t)(row - NLAT) * D) : H + (size_t)row * D) + col0; float* dp = H + (size_t)row * D + col0;
#pragma unroll
                for (int bj = 0; bj < 2; ++bj)
#pragma unroll
                    for (int n = 0; n < 2; ++n) { const f32x4 s = *(const f32x4*)(sp + bj * 128 + n * 16); *(f32x4*)(dp + bj * 128 + n * 16) = s + mm[bj][n] * acc[ai][bj][m][n]; }
                asm volatile("" ::: "memory"); }
    }
};
struct EpiF32Part {
    static constexpr bool PERM = false, AFTER_DRAIN = false; float* P;
    __device__ __forceinline__ void operator()(EPI_ARGS) const {
        const int row0 = u.pm * 256 + wr * 64 + fr, col0 = u.pn * 256 + wc * 32 + 4 * fq;
#pragma unroll
        for (int ai = 0; ai < 2; ++ai)
#pragma unroll
            for (int m = 0; m < 4; ++m) { float* dp = P + (size_t)(row0 + ai * 128 + m * 16) * D + col0;
#pragma unroll
                for (int bj = 0; bj < 2; ++bj)
#pragma unroll
                    for (int n = 0; n < 2; ++n) *(f32x4*)(dp + bj * 128 + n * 16) = acc[ai][bj][m][n]; }
    }
};
struct EpiHgIn {
    static constexpr bool PERM = false, AFTER_DRAIN = false; u16* base; const float* lb;
    __device__ __forceinline__ void operator()(EPI_ARGS) const {
        const int kind = u.pn >> 2; const int row0 = u.pm * 256 + wr * 64 + fr, col0 = (u.pn & 3) * 256 + wc * 32 + 4 * fq;
        u16* dst = base + (size_t)kind * (T16 / 2);
        if (kind == 1 || kind == 2) {
            f32x4 l4[2][2], s4[2][2];
#pragma unroll
            for (int bj = 0; bj < 2; ++bj)
#pragma unroll
                for (int n = 0; n < 2; ++n) { l4[bj][n] = *(const f32x4*)(lb + (kind - 1) * D + col0 + bj * 128 + n * 16); s4[bj][n] = (1.0f - l4[bj][n]) * 65535.0f; l4[bj][n] = l4[bj][n] * 65535.0f + 0.5f; }
#pragma unroll
            for (int ai = 0; ai < 2; ++ai)
#pragma unroll
                for (int m = 0; m < 4; ++m) { u16* rp = dst + (size_t)(row0 + ai * 128 + m * 16) * D + col0;
#pragma unroll
                    for (int bj = 0; bj < 2; ++bj)
#pragma unroll
                        for (int n = 0; n < 2; ++n) { const f32x4 v = acc[ai][bj][m][n]; unsigned q[4];
#pragma unroll
                            for (int e = 0; e < 4; ++e) q[e] = (unsigned)(l4[bj][n][e] + s4[bj][n][e] * sigmoidf_(v[e]));
                            u32x2 w; w.x = q[0] | (q[1] << 16); w.y = q[2] | (q[3] << 16); *(u32x2*)(rp + bj * 128 + n * 16) = w; } }
        } else {
#pragma unroll
            for (int ai = 0; ai < 2; ++ai)
#pragma unroll
                for (int m = 0; m < 4; ++m) { u16* rp = dst + (size_t)(row0 + ai * 128 + m * 16) * D + col0;
#pragma unroll
                    for (int bj = 0; bj < 2; ++bj)
#pragma unroll
                        for (int n = 0; n < 2; ++n) { const f32x4 v = acc[ai][bj][m][n]; u32x2 w;
                            if (kind == 4) { w.x = pk_bf16(siluf_(v[0]), siluf_(v[1])); w.y = pk_bf16(siluf_(v[2]), siluf_(v[3])); }
                            else { w.x = pk_bf16(v[0], v[1]); w.y = pk_bf16(v[2], v[3]); }
                            *(u32x2*)(rp + bj * 128 + n * 16) = w; } }
        }
    }
};
struct EpiMlaDown {
    static constexpr bool PERM = false, AFTER_DRAIN = false; float* dproj; bf16_t* kr; const float* rope;
    __device__ __forceinline__ void operator()(EPI_ARGS) const {
        const int row0 = u.pm * 256 + wr * 64 + fr;
#pragma unroll
        for (int bj = 0; bj < 2; ++bj) { const int gcol = u.pn * 256 + bj * 128 + wc * 32;
            if (gcol < 640) {
#pragma unroll
                for (int ai = 0; ai < 2; ++ai)
#pragma unroll
                    for (int m = 0; m < 4; ++m) { float* rp = dproj + (size_t)(row0 + ai * 128 + m * 16) * 640 + gcol + 4 * fq;
                        *(f32x4*)rp = acc[ai][bj][m][0]; *(f32x4*)(rp + 16) = acc[ai][bj][m][1]; }
            } else if (gcol < 704) { const int axis = (gcol - 640) >> 5;
#pragma unroll
                for (int ai = 0; ai < 2; ++ai)
#pragma unroll
                    for (int m = 0; m < 4; ++m) { const int row = row0 + ai * 128 + m * 16; f32x4 a = acc[ai][bj][m][0], b = acc[ai][bj][m][1];
                        if (row < NLAT) { const int pos = row & 4095, P = axis ? (pos & 63) : (pos >> 6); const float* cs = rope + (P * 16 + 4 * fq) * 2;
                            const f32x4 c0 = *(const f32x4*)cs, c1 = *(const f32x4*)(cs + 4);
                            const f32x4 cv = {c0[0], c0[2], c1[0], c1[2]}, sv = {c0[1], c0[3], c1[1], c1[3]};
                            const f32x4 na = a * cv - b * sv, nb = a * sv + b * cv; a = na; b = nb; }
                        bf16_t* rp = kr + (size_t)row * 64 + axis * 32 + 4 * fq; u32x2 w;
                        w.x = pk_bf16(a[0], a[1]); w.y = pk_bf16(a[2], a[3]); *(u32x2*)rp = w;
                        w.x = pk_bf16(b[0], b[1]); w.y = pk_bf16(b[2], b[3]); *(u32x2*)(rp + 16) = w; asm volatile("" ::: "memory"); }
            }
        }
    }
};
struct EpiBf16 {
    static constexpr bool PERM = false, AFTER_DRAIN = false; bf16_t* o; size_t ldc; float scale;
    __device__ __forceinline__ void operator()(EPI_ARGS) const {
        const int row0 = u.pm * 256 + wr * 64 + fr, col0 = u.pn * 256 + wc * 32 + 4 * fq;
#pragma unroll
        for (int ai = 0; ai < 2; ++ai)
#pragma unroll
            for (int m = 0; m < 4; ++m) { bf16_t* rp = o + (size_t)(row0 + ai * 128 + m * 16) * ldc + col0;
#pragma unroll
                for (int bj = 0; bj < 2; ++bj)
#pragma unroll
                    for (int n = 0; n < 2; ++n) { const f32x4 v = acc[ai][bj][m][n] * scale; u32x2 w; w.x = pk_bf16(v[0], v[1]); w.y = pk_bf16(v[2], v[3]); *(u32x2*)(rp + bj * 128 + n * 16) = w; } }
    }
};
template <class Epi> __device__ __forceinline__ void run_gemm(LAS unsigned char* lds, const bf16_t* A, const bf16_t* Bt, int M, int N, int K, const Epi& E, int ld = 0, int rot = 0) {
    pg8::Gemm g; g.A = A; g.Bt = Bt; g.M = M; g.N = N; g.K = K; g.ld = ld ? ld : K;
    pg8::StaticOrder S; S.init(M, N, gridDim.x, (blockIdx.x + gridDim.x - rot) % gridDim.x);
    pg8::gemm_phase<Epi, pg8::StaticOrder, false>(lds, g, S, E, nullptr);
}
template <int KTOT> __device__ __forceinline__ void resid_latent(LAS unsigned char* lds, const Params& p, const bf16_t* A, const bf16_t* Wt, float* H, const float* modl, int midx, float coef, int from_input) {
    EpiResid e; e.x = p.x; e.ctx = p.ctx; e.H = H; e.modl = modl; e.midx = midx; e.coef = coef; e.from_input = from_input; e.row_off = 0; run_gemm(lds, A, Wt, NLAT, D, KTOT, e);
}
template <int KTOT> __device__ __forceinline__ void resid_ctx(LAS unsigned char* lds, const bf16_t* A, const bf16_t* Wt, float* P) {
    EpiF32Part e; e.P = P; run_gemm(lds, A + (size_t)NLAT * KTOT, Wt, NCTX, D, KTOT, e, KTOT, 0);
}

__device__ __forceinline__ const float* conv_src(int kind, const float* s0, const float* s1, int R) {
    switch (kind) {
        case 1: return ((R >> 4) & 1 ? s1 : s0) + (R >> 5) * 16 + (R & 15);
        case 2: return s0 + (R >> 7) * 256 + (R & 127);
        case 3: return s0 + (R >> 7) * 256 + 128 + (R & 127);
        case 4: return R < 704 ? s0 + R : nullptr;
        default: return s0 + R;
    }
}
__device__ __forceinline__ void conv_T(unsigned char* smem, int kind, const float* s0, const float* s1, int ldn, int Ndst, int K, bf16_t* dst, int rot, int wg_lo = 0) {
    float* tile = (float*)smem;
    const int tid = fresh_tid(), nkb = K / 64, ntiles = (Ndst / 64) * nkb, G = (int)gridDim.x - wg_lo;
    for (int t = ((int)blockIdx.x - wg_lo + rot) % G; t < ntiles; t += G) {
        const int R0 = (t / nkb) * 64, k0 = (t % nkb) * 64;
        { const int Rl = tid & 63, kr = tid >> 6; const float* sp = conv_src(kind, s0, s1, R0 + Rl);
#pragma unroll
            for (int ps = 0; ps < 8; ++ps) { const int kl = ps * 8 + kr; tile[Rl * 65 + kl] = sp ? sp[(size_t)(k0 + kl) * ldn] : 0.f; } }
        __syncthreads();
        { const int Rl = tid >> 3, c = tid & 7; const float* s = tile + Rl * 65 + 8 * c; u32x4 w;
            w.x = pk_bf16(s[0], s[1]); w.y = pk_bf16(s[2], s[3]); w.z = pk_bf16(s[4], s[5]); w.w = pk_bf16(s[6], s[7]);
            *(u32x4*)(dst + (size_t)(R0 + Rl) * K + k0 + 8 * c) = w; }
        __syncthreads();
    }
}
__device__ __forceinline__ void convert_layer(const Params& p, unsigned char* smem, int layer, int part = 3, int wg_lo = 0) {
    bf16_t* W = (bf16_t*)(p.ws + OFF_W);
    for (int s = 0; s < 2; ++s) {
        const size_t o = ((size_t)layer * 2 + s) * D * FH;
        if (part & 1) conv_T(smem, 1, p.w_gate + o, p.w_up + o, FH, 2 * FH, D, W + (s ? W_GU1 : W_GU0), s * 64, wg_lo);
        if (part & (s ? 2 : 1)) conv_T(smem, 0, p.w_down + o, nullptr, D, D, FH, W + (s ? W_D1 : W_D0), s * 64 + 32, wg_lo);
    }
    if (!(part & 1)) return;
    const int j = layer >> 1;
    if ((layer & 1) == 0) {
        conv_T(smem, 0, p.hg_w_in + (size_t)j * D * 5120, nullptr, 5120, 5120, D, W + W_IN, 128, wg_lo);
        conv_T(smem, 0, p.hg_w_out + (size_t)j * D * D, nullptr, D, D, D, W + W_OUT, 160, wg_lo);
    } else {
        conv_T(smem, 4, p.mla_w_down + (size_t)j * D * 704, nullptr, 704, 768, D, W + W_DN, 128, wg_lo);
        conv_T(smem, 0, p.mla_w_uq + (size_t)j * 384 * 1536, nullptr, 1536, 1536, 384, W + W_UQ, 176, wg_lo);
        conv_T(smem, 2, p.mla_w_ukv + (size_t)j * 256 * 2048, nullptr, 2048, 1024, 256, W + W_K, 200, wg_lo);
        conv_T(smem, 3, p.mla_w_ukv + (size_t)j * 256 * 2048, nullptr, 2048, 1024, 256, W + W_V, 216, wg_lo);
        conv_T(smem, 0, p.mla_w_o + (size_t)j * D * D, nullptr, D, D, D, W + W_O, 232, wg_lo);
    }
}
__device__ __forceinline__ void phase_prologue(const Params& p, unsigned char* smem, int l0, int l1, int wg_lo, bool tables) {
    float* sS = (float*)smem;
    float* sP = sS + 9 * 1024;
    const int tid = fresh_tid(), wave = tid >> 6, lane = tid & 63;
    for (int i = tid; i < 9 * 1024; i += 512) { const float v = i < 8192 ? p.c[i] : p.c_ctx[i - 8192]; sS[i] = siluf_(v); }
    __syncthreads();
    float* mod = (float*)(p.ws + OFF_MOD);
    for (int item = (int)blockIdx.x - wg_lo; item < (l1 - l0) * 144; item += (int)gridDim.x - wg_lo) {
        const int l = l0 + item / 144, j0 = (item % 144) * 64; const float* wp = p.mod_w + (size_t)l * D * (NMOD * D) + j0 + lane;
        float a[9];
#pragma unroll
        for (int r = 0; r < 9; ++r) a[r] = 0.f;
#pragma unroll 8
        for (int kk = 0; kk < 128; ++kk) { const int k = wave * 128 + kk; const float w = wp[(size_t)k * (NMOD * D)];
#pragma unroll
            for (int r = 0; r < 9; ++r) a[r] += sS[r * 1024 + k] * w; }
#pragma unroll
        for (int r = 0; r < 9; ++r) sP[(wave * 9 + r) * 64 + lane] = a[r];
        __syncthreads();
        for (int i = tid; i < 9 * 64; i += 512) { const int r = i >> 6, jl = i & 63; float s = p.mod_b[(size_t)l * (NMOD * D) + j0 + jl];
#pragma unroll
            for (int w = 0; w < 8; ++w) s += sP[(w * 9 + r) * 64 + jl];
            mod[((size_t)l * 9 + r) * (NMOD * D) + j0 + jl] = s; }
        __syncthreads();
    }
    if (!tables) return;
    const int gt = blockIdx.x * 512 + tid;
    if (gt < 4096) { float* lb = (float*)(p.ws + OFF_LB); const int idx = gt & 2047;
        if (gt < 2048) lb[gt] = 0.f; else lb[gt] = sigmoidf_(p.hg_lb[2048 + idx] - p.hg_lb[idx]); }
    if (gt >= 4096 && gt < 4096 + 1024) { float* rt = (float*)(p.ws + OFF_ROPE); const int i = gt - 4096, P = i >> 4, j = i & 15;
        const float inv = exp2f(-(float)j * (13.287712379549449f / 16.0f)); const float xa = (float)P * inv;
        const float kq = __builtin_rintf(xa * 0.15915494309189535f); float r = fmaf(-kq, 6.28125f, xa); r = fmaf(-kq, 1.9353071795864769e-3f, r);
        rt[2 * i] = cosf(r); rt[2 * i + 1] = sinf(r); }
}
__device__ __forceinline__ void phase_norm(const Params& p, int layer, int gi, int mbase, int from_input, const float* P, int player, int pmidx, float pcoef, int ctx_from_input, int row_lo, int row_hi, int wg_lo) {
    const int tid = fresh_tid(); const int lane = tid & 63, gw = ((int)blockIdx.x - wg_lo) * 8 + (tid >> 6), nw = ((int)gridDim.x - wg_lo) * 8;
    const float* H = (const float*)(p.ws + OFF_H); bf16_t* A = (bf16_t*)(p.ws + OFF_A);
    const float* modl = (const float*)(p.ws + OFF_MOD) + (size_t)layer * 9 * (NMOD * D); const float* g = p.norm_g + ((size_t)layer * 3 + gi) * D;
    const int chunk = (row_hi - row_lo + nw - 1) / nw; const int r0 = row_lo + gw * chunk, r1 = (r0 + chunk < row_hi) ? r0 + chunk : row_hi;
    f32x4 gs[4], sh[4]; int cur_mr = -1;
    for (int row = r0; row < r1; ++row) {
        const float* hp = (from_input || (ctx_from_input && row >= NLAT)) ? in_row(p, row) : H + (size_t)row * D;
        const int mrow_i = mod_row(row);
        if (mrow_i != cur_mr) { cur_mr = mrow_i; const float* mr = modl + (size_t)mrow_i * (NMOD * D) + mbase * D;
#pragma unroll
            for (int j = 0; j < 4; ++j) { const int c = 4 * lane + 256 * j; gs[j] = *(const f32x4*)(g + c) * (*(const f32x4*)(mr + D + c) + 1.0f); sh[j] = *(const f32x4*)(mr + c); } }
        f32x4 v[4]; float s = 0.f;
#pragma unroll
        for (int j = 0; j < 4; ++j) v[j] = *(const f32x4*)(hp + 4 * lane + 256 * j);
        if (P != nullptr && row >= NLAT) {
            const float* pr = P + (size_t)(row - NLAT) * D; const float* pm = (const float*)(p.ws + OFF_MOD) + ((size_t)player * 9 + 8) * (NMOD * D) + pmidx * D; float* hw = (float*)(p.ws + OFF_H) + (size_t)row * D;
#pragma unroll
            for (int j = 0; j < 4; ++j) { const int c = 4 * lane + 256 * j; const f32x4 t = *(const f32x4*)(pr + c);
                v[j] = v[j] + (*(const f32x4*)(pm + c) * pcoef) * t; *(f32x4*)(hw + c) = v[j]; }
        }
#pragma unroll
        for (int j = 0; j < 4; ++j) s += (v[j][0] * v[j][0] + v[j][1] * v[j][1]) + (v[j][2] * v[j][2] + v[j][3] * v[j][3]);
        const float rstd = __builtin_amdgcn_rsqf(wave_sum(s) * (1.0f / D) + 1e-6f);
#pragma unroll
        for (int j = 0; j < 4; ++j) { const int c = 4 * lane + 256 * j;
            const f32x4 y = (v[j] * rstd) * gs[j] + sh[j]; u32x2 w; w.x = pk_bf16(y[0], y[1]); w.y = pk_bf16(y[2], y[3]); *(u32x2*)(A + (size_t)row * D + c) = w; }
    }
}
__device__ __forceinline__ void phase_final(const Params& p) {
    const int tid = fresh_tid(); const int lane = tid & 63, gw = blockIdx.x * 8 + (tid >> 6), nw = gridDim.x * 8; const float* H = (const float*)(p.ws + OFF_H);
    for (int row = gw; row < NLAT; row += nw) { const float* hp = H + (size_t)row * D; f32x4 v[4]; float s = 0.f;
#pragma unroll
        for (int j = 0; j < 4; ++j) { v[j] = *(const f32x4*)(hp + 4 * lane + 256 * j); s += (v[j][0] * v[j][0] + v[j][1] * v[j][1]) + (v[j][2] * v[j][2] + v[j][3] * v[j][3]); }
        const float rstd = __builtin_amdgcn_rsqf(wave_sum(s) * (1.0f / D) + 1e-6f);
#pragma unroll
        for (int j = 0; j < 4; ++j) { const int c = 4 * lane + 256 * j; *(f32x4*)(p.out + (size_t)row * D + c) = v[j] * rstd * *(const f32x4*)(p.final_g + c); } }
}
__device__ __forceinline__ void phase_readout(const Params& p, int j) {
    const int tid = fresh_tid(); const int lane = tid & 63, gw = blockIdx.x * 8 + (tid >> 6), nw = gridDim.x * 8;
    const bf16_t* O = (const bf16_t*)(p.ws + OFF_A); const bf16_t* SG = (const bf16_t*)(p.ws + OFF_BIG + 4 * T16); bf16_t* R = (bf16_t*)(p.ws + OFF_BIG);
    const float* gn = p.hg_gn + (size_t)j * 128 + (lane & 7) * 16;
    for (int row = gw; row < MTOK; row += nw) { const size_t off = (size_t)row * D + 16 * lane;
        const u32x4 o0 = *(const u32x4*)(O + off), o1 = *(const u32x4*)(O + off + 8), g0 = *(const u32x4*)(SG + off), g1 = *(const u32x4*)(SG + off + 8);
        float ov[16], gv[16];
#pragma unroll
        for (int e = 0; e < 4; ++e) { ov[2 * e] = bf_lo(o0[e]); ov[2 * e + 1] = bf_hi(o0[e]); ov[8 + 2 * e] = bf_lo(o1[e]); ov[9 + 2 * e] = bf_hi(o1[e]);
            gv[2 * e] = bf_lo(g0[e]); gv[2 * e + 1] = bf_hi(g0[e]); gv[8 + 2 * e] = bf_lo(g1[e]); gv[9 + 2 * e] = bf_hi(g1[e]); }
        float s = 0.f;
#pragma unroll
        for (int e = 0; e < 16; ++e) s += ov[e] * ov[e];
        s += __shfl_xor(s, 1); s += __shfl_xor(s, 2); s += __shfl_xor(s, 4);
        const float rstd = __builtin_amdgcn_rsqf(s * (1.0f / 128.0f) + 1e-6f); u32x4 w0, w1;
#pragma unroll
        for (int e = 0; e < 4; ++e) { w0[e] = pk_bf16(ov[2 * e] * rstd * gn[2 * e] * gv[2 * e], ov[2 * e + 1] * rstd * gn[2 * e + 1] * gv[2 * e + 1]);
            w1[e] = pk_bf16(ov[8 + 2 * e] * rstd * gn[8 + 2 * e] * gv[8 + 2 * e], ov[9 + 2 * e] * rstd * gn[9 + 2 * e] * gv[9 + 2 * e]); }
        *(u32x4*)(R + off) = w0; *(u32x4*)(R + off + 8) = w1; }
}
__device__ __forceinline__ void phase_mla_norm(const Params& p, int j) {
    const int tid = fresh_tid(); const int lane = tid & 63, gw = blockIdx.x * 8 + (tid >> 6), nw = gridDim.x * 8;
    const float* DP = (const float*)(p.ws + OFF_BIG); bf16_t* CQN = (bf16_t*)(p.ws + OFF_BIG + 106954752 + 2 * T16); bf16_t* CKVN = CQN + (size_t)MTOK * 384;
    const float* qn = p.mla_q_norm + (size_t)j * 384; const float* kn = p.mla_kv_norm + (size_t)j * 256;
    for (int row = gw; row < MTOK; row += nw) { const float* dp = DP + (size_t)row * 640;
        f32x2 a[3]; float s = 0.f;
#pragma unroll
        for (int t = 0; t < 3; ++t) { a[t] = *(const f32x2*)(dp + 2 * lane + 128 * t); s += a[t][0] * a[t][0] + a[t][1] * a[t][1]; }
        const f32x4 b = *(const f32x4*)(dp + 384 + 4 * lane); const float s2 = (b[0] * b[0] + b[1] * b[1]) + (b[2] * b[2] + b[3] * b[3]);
        const float r1 = __builtin_amdgcn_rsqf(wave_sum(s) * (1.0f / 384.0f) + 1e-6f), r2 = __builtin_amdgcn_rsqf(wave_sum(s2) * (1.0f / 256.0f) + 1e-6f);
#pragma unroll
        for (int t = 0; t < 3; ++t) { const int c = 2 * lane + 128 * t; *(unsigned*)(CQN + (size_t)row * 384 + c) = pk_bf16(a[t][0] * r1 * qn[c], a[t][1] * r1 * qn[c + 1]); }
        { const int c = 4 * lane; u32x2 w; w.x = pk_bf16(b[0] * r2 * kn[c], b[1] * r2 * kn[c + 1]); w.y = pk_bf16(b[2] * r2 * kn[c + 2], b[3] * r2 * kn[c + 3]); *(u32x2*)(CKVN + (size_t)row * 256 + c) = w; } }
}

__device__ __forceinline__ float dpp_xor1(float v) { return __int_as_float(__builtin_amdgcn_update_dpp(0, __float_as_int(v), 0xB1, 0xF, 0xF, true)); }
__device__ __forceinline__ float dpp_xor2(float v) { return __int_as_float(__builtin_amdgcn_update_dpp(0, __float_as_int(v), 0x4E, 0xF, 0xF, true)); }
__device__ __forceinline__ float dpp_hmir(float v) { return __int_as_float(__builtin_amdgcn_update_dpp(0, __float_as_int(v), 0x141, 0xF, 0xF, true)); }
constexpr int SNB = 272;
__device__ __forceinline__ int scan_block(int dir, int i) { return dir == 0 ? i : (i < 16 ? 15 - i : 287 - i); }
__device__ __forceinline__ int scan_row(int b, int X, int tt) { return X < 16 ? NLAT + b * CTXL + X * 16 + tt : b * SEQ + (X - 16) * 16 + tt; }
__device__ __forceinline__ void phase_scan(const Params& p, unsigned char* smem) {
    float* sF = (float*)smem;
    float* sQ = sF + 2 * 2 * 16 * 128;
    float* sV = sQ + 2 * 2 * 16 * 128;
    float* sVN = sV + 2 * 2 * 16 * 32;
    float* sPO = sVN + 3 * 2 * 16 * 32;
    float* sQS = sPO + 2 * 2 * 16 * 8 * 32;
    const u16* QH = (const u16*)(p.ws + OFF_BIG); const u16* FF = QH + T16 / 2; const u16* FB = FF + T16 / 2; const u16* VI = FB + T16 / 2; bf16_t* O = (bf16_t*)(p.ws + OFF_A);
    const int tid = fresh_tid(), wave = __builtin_amdgcn_readfirstlane(tid >> 6), lane = tid & 63;
    for (int task = blockIdx.x; task < 256; task += gridDim.x) {
        const int b = task >> 5, h = (task >> 2) & 7, vq = task & 3;
        if (wave < 4) {
            const int dir = wave >> 1, khalf = wave & 1, ksub = lane & 7, vg = lane >> 3, kbase = khalf * 64 + ksub * 8;
            f32x2 S2[8][2];
            { const u32x2 w0 = *(const u32x2*)(VI + (size_t)scan_row(b, scan_block(dir, 0), dir ? 15 : 0) * D + h * 128 + vq * 32 + 4 * vg);
              const f32x2 iA = {-bf_lo(w0.x), -bf_hi(w0.x)}, iB = {-bf_lo(w0.y), -bf_hi(w0.y)};
#pragma unroll
              for (int e = 0; e < 8; ++e) { S2[e][0] = iA; S2[e][1] = iB; } }
            __syncthreads();
            for (int it = 0; it < SNB; ++it) { const int buf = it & 1;
                const float* bF = sF + (buf * 2 + dir) * 16 * 128 + kbase; const float* bQ = sQ + (buf * 2 + dir) * 16 * 128 + kbase; const float* bV = sV + (buf * 2 + dir) * 16 * 32 + 4 * vg;
                float* bP = sPO + ((buf * 2 + dir) * 16 * 8 + khalf * 4 + (ksub >> 1)) * 32 + 4 * vg;
#define SC_LD(X, s_) do { const int tt_ = dir ? 15 - (s_) : (s_); X##f0 = *(const f32x4*)(bF + tt_ * 128); X##f1 = *(const f32x4*)(bF + tt_ * 128 + 4); \
                    X##q0 = *(const f32x4*)(bQ + tt_ * 128); X##q1 = *(const f32x4*)(bQ + tt_ * 128 + 4); X##vv = *(const f32x4*)(bV + tt_ * 32); } while (0)
#define SC_STEP(X, s_) do { const int tt_ = dir ? 15 - (s_) : (s_); f32x2 oA = {0.f, 0.f}, oB = {0.f, 0.f}; const f32x2 vA = {X##vv[0], X##vv[1]}, vB = {X##vv[2], X##vv[3]}; \
                    _Pragma("unroll") for (int k = 0; k < 8; ++k) { const float f = k < 4 ? X##f0[k & 3] : X##f1[k & 3], q = k < 4 ? X##q0[k & 3] : X##q1[k & 3]; const f32x2 fb = {f, f}, qb = {q, q}; \
                        S2[k][0] = __builtin_elementwise_fma(fb, S2[k][0], vA); S2[k][1] = __builtin_elementwise_fma(fb, S2[k][1], vB); \
                        oA = __builtin_elementwise_fma(S2[k][0], qb, oA); oB = __builtin_elementwise_fma(S2[k][1], qb, oB); } \
                    f32x4 o = {oA[0], oA[1], oB[0], oB[1]}; \
                    _Pragma("unroll") for (int e = 0; e < 4; ++e) { o[e] += dpp_xor1(o[e]); } \
                    *(f32x4*)(bP + tt_ * 256) = o; } while (0)
                f32x4 Af0, Af1, Aq0, Aq1, Avv, Bf0, Bf1, Bq0, Bq1, Bvv;
                SC_LD(A, 0);
#pragma unroll
                for (int s = 0; s < 16; s += 2) { SC_LD(B, s + 1); SC_STEP(A, s); SC_LD(A, (s + 2 < 16 ? s + 2 : 15)); SC_STEP(B, s + 1); }
#undef SC_LD
#undef SC_STEP
                __syncthreads();
            }
            __syncthreads();
        } else {
            const int ht = tid - 256, stt = ht >> 4, sc = ht & 15, vdir = ht >> 6, vtt = (ht & 63) >> 2, vc = ht & 3, ftt = ht >> 3, fv4 = ht & 7;
            u32x4 rf[2], rq[2], rv, rvn;
#define SC_GLOAD(it_) do { _Pragma("unroll") for (int d = 0; d < 2; ++d) { const size_t ro = (size_t)scan_row(b, scan_block(d, (it_)), stt) * D + h * 128 + 8 * sc; \
                rf[d] = *(const u32x4*)((d ? FB : FF) + ro); rq[d] = *(const u32x4*)(QH + ro); } \
                if (ht < 128) { rv = *(const u32x4*)(VI + (size_t)scan_row(b, scan_block(vdir, (it_)), vtt) * D + h * 128 + vq * 32 + 8 * vc); \
                    const int s_ = vdir ? 15 - vtt : vtt; const bool inblk = s_ < 15; const int nit = inblk ? (it_) : (it_) + 1; const int ntt = inblk ? (vdir ? vtt - 1 : vtt + 1) : (vdir ? 15 : 0); \
                    rvn = (u32x4){0u, 0u, 0u, 0u}; if (nit < SNB) rvn = *(const u32x4*)(VI + (size_t)scan_row(b, scan_block(vdir, nit), ntt) * D + h * 128 + vq * 32 + 8 * vc); } } while (0)
#define SC_LSTORE(buf_, ring_) do { _Pragma("unroll") for (int d = 0; d < 2; ++d) { float* fp = sF + (((buf_) * 2 + d) * 16 + stt) * 128 + 8 * sc; float* qp = sQ + (((buf_) * 2 + d) * 16 + stt) * 128 + 8 * sc; f32x4 a0, a1, b0, b1; \
                a0[0] = (float)(rf[d][0] & 0xffffu); a0[1] = (float)(rf[d][0] >> 16); a0[2] = (float)(rf[d][1] & 0xffffu); a0[3] = (float)(rf[d][1] >> 16); \
                a1[0] = (float)(rf[d][2] & 0xffffu); a1[1] = (float)(rf[d][2] >> 16); a1[2] = (float)(rf[d][3] & 0xffffu); a1[3] = (float)(rf[d][3] >> 16); \
                b0[0] = bf_lo(rq[d][0]); b0[1] = bf_hi(rq[d][0]); b0[2] = bf_lo(rq[d][1]); b0[3] = bf_hi(rq[d][1]); b1[0] = bf_lo(rq[d][2]); b1[1] = bf_hi(rq[d][2]); b1[2] = bf_lo(rq[d][3]); b1[3] = bf_hi(rq[d][3]); \
                *(f32x4*)fp = a0 * (1.0f / 65535.0f); *(f32x4*)(fp + 4) = a1 * (1.0f / 65535.0f); *(f32x4*)qp = b0; *(f32x4*)(qp + 4) = b1; \
                sQS[(((ring_) * 2 + d) * 16 + stt) * 16 + sc] = ((b0[0] + b0[1]) + (b0[2] + b0[3])) + ((b1[0] + b1[1]) + (b1[2] + b1[3])); } \
                if (ht < 128) { float* vp = sV + (((buf_) * 2 + vdir) * 16 + vtt) * 32 + 8 * vc; float* np = sVN + (((ring_) * 2 + vdir) * 16 + vtt) * 32 + 8 * vc; f32x4 c0, c1, n0, n1; \
                    c0[0] = bf_lo(rv[0]); c0[1] = bf_hi(rv[0]); c0[2] = bf_lo(rv[1]); c0[3] = bf_hi(rv[1]); c1[0] = bf_lo(rv[2]); c1[1] = bf_hi(rv[2]); c1[2] = bf_lo(rv[3]); c1[3] = bf_hi(rv[3]); \
                    n0[0] = bf_lo(rvn[0]); n0[1] = bf_hi(rvn[0]); n0[2] = bf_lo(rvn[1]); n0[3] = bf_hi(rvn[1]); n1[0] = bf_lo(rvn[2]); n1[1] = bf_hi(rvn[2]); n1[2] = bf_lo(rvn[3]); n1[3] = bf_hi(rvn[3]); \
                    *(f32x4*)vp = c0 - n0; *(f32x4*)(vp + 4) = c1 - n1; *(f32x4*)np = n0; *(f32x4*)(np + 4) = n1; } } while (0)
#define SC_FINAL(it_) do { if (ht < 128) { const int fb_ = (it_) & 1; u32x2 pv[2]; bf16_t* op[2]; bool rmw[2]; \
                _Pragma("unroll") for (int d = 0; d < 2; ++d) { const int X = scan_block(d, (it_)); const int other = d == 0 ? (X < 16 ? 15 - X : 287 - X) : X; rmw[d] = (it_) > other; \
                    op[d] = O + (size_t)scan_row(b, X, ftt) * D + h * 128 + vq * 32 + 4 * fv4; if (rmw[d]) pv[d] = *(const u32x2*)op[d]; } \
                _Pragma("unroll") for (int d = 0; d < 2; ++d) { const float* pp = sPO + ((fb_ * 2 + d) * 16 + ftt) * 256 + 4 * fv4; f32x4 o = ((*(const f32x4*)pp + *(const f32x4*)(pp + 32)) + (*(const f32x4*)(pp + 64) + *(const f32x4*)(pp + 96))) + ((*(const f32x4*)(pp + 128) + *(const f32x4*)(pp + 160)) + (*(const f32x4*)(pp + 192) + *(const f32x4*)(pp + 224))); \
                    { const int rg_ = (it_) % 3; const float* qsp = sQS + ((rg_ * 2 + d) * 16 + ftt) * 16; const f32x4 c4 = (*(const f32x4*)qsp + *(const f32x4*)(qsp + 4)) + (*(const f32x4*)(qsp + 8) + *(const f32x4*)(qsp + 12)); \
                      const float ct = (c4[0] + c4[1]) + (c4[2] + c4[3]); o = o + ct * *(const f32x4*)(sVN + ((rg_ * 2 + d) * 16 + ftt) * 32 + 4 * fv4); }     \
                    if (rmw[d]) { o[0] += bf_lo(pv[d].x); o[1] += bf_hi(pv[d].x); o[2] += bf_lo(pv[d].y); o[3] += bf_hi(pv[d].y); } \
                    u32x2 w; w.x = pk_bf16(o[0], o[1]); w.y = pk_bf16(o[2], o[3]); *(u32x2*)op[d] = w; } } } while (0)
            SC_GLOAD(0); SC_LSTORE(0, 0); SC_GLOAD(1);
            __syncthreads();
            for (int it = 0; it < SNB; ++it) {
                if (it + 1 < SNB) SC_LSTORE((it + 1) & 1, (it + 1) % 3);
                if (it + 2 < SNB) SC_GLOAD(it + 2);
                if (it > 0) SC_FINAL(it - 1);
                __syncthreads();
            }
            SC_FINAL(SNB - 1);
            __syncthreads();
#undef SC_GLOAD
#undef SC_LSTORE
#undef SC_FINAL
        }
    }
}

constexpr int KNROW = 256, KRROW = 128, VROW = 128, KNBUF = 64 * KNROW, KRBUF = 64 * KRROW, VBUF = 128 * VROW, ATT_STAGE = KNBUF + KRBUF + VBUF;
__device__ __forceinline__ void phase_attn(const Params& p, unsigned char* smem, bool with_ctx) {
    const bf16_t* QB = (const bf16_t*)(p.ws + OFF_BIG); const bf16_t* KN = QB + (size_t)MTOK * 1536; const bf16_t* VT = KN + (size_t)MTOK * D;
    const bf16_t* KR = VT + (size_t)MTOK * D + (size_t)MTOK * 384 + (size_t)MTOK * 256; bf16_t* AO = (bf16_t*)(p.ws + OFF_A);
    LAS unsigned char* lds = (LAS unsigned char*)smem;
    const int tid = fresh_tid(), wave = __builtin_amdgcn_readfirstlane(tid >> 6), lane = tid & 63, fr = lane & 15, fq = lane >> 4;
    const int nrounds = with_ctx ? 5 : 4; const int xcd = blockIdx.x & 7, jx = blockIdx.x >> 3;
    if (wave >= 4) __builtin_amdgcn_s_setprio(1);
    for (int rnd = 0; rnd < nrounds; ++rnd) {
        int b, head, qrow0, t0;
        if (rnd < 4) { const int grp = xcd * 8 + rnd * 2 + (jx >> 4); b = grp >> 3; head = grp & 7; qrow0 = b * SEQ + (jx & 15) * 256; t0 = 0; }
        else { if (blockIdx.x >= 64) break; b = blockIdx.x >> 3; head = blockIdx.x & 7; qrow0 = NLAT + b * CTXL; t0 = 64; }
        unsigned doff[5];
#pragma unroll
        for (int i = 0; i < 2; ++i) { const int ci = 64 * (wave + 8 * i) + lane, rho = ci >> 4, c = (ci & 15) ^ (rho & 15), ii = rho & 15, key = (rho & 32) + 8 * (ii >> 2) + 4 * ((rho >> 4) & 1) + (ii & 3);
            doff[i] = (unsigned)(key * D + head * 128 + 8 * c); }
        { const int ci = 64 * wave + lane, rho = ci >> 3, c = (ci & 7) ^ ((rho >> 1) & 7), ii = rho & 15, key = (rho & 32) + 8 * (ii >> 2) + 4 * ((rho >> 4) & 1) + (ii & 3); doff[2] = (unsigned)(key * 64 + 8 * c); }
#pragma unroll
        for (int i = 0; i < 2; ++i) { const int ci = 64 * (wave + 8 * i) + lane, vcol = ci >> 3, c = (ci & 7) ^ ((vcol >> 1) & 7); doff[3 + i] = (unsigned)((head * 128 + vcol) * MTOK + 8 * c); }
#define ATT_DMA(t, buf) do { const int tok0 = (t) < 64 ? b * SEQ + (t) * 64 : NLAT + b * CTXL + ((t) - 64) * 64; LAS unsigned char* st_ = lds + (buf) * ATT_STAGE; \
            __builtin_amdgcn_global_load_lds((const unsigned*)(KN + (size_t)tok0 * D + doff[0]), (LAS unsigned*)(st_ + wave * 1024), 16, 0, 0); \
            __builtin_amdgcn_global_load_lds((const unsigned*)(KN + (size_t)tok0 * D + doff[1]), (LAS unsigned*)(st_ + (wave + 8) * 1024), 16, 0, 0); \
            __builtin_amdgcn_global_load_lds((const unsigned*)(KR + (size_t)tok0 * 64 + doff[2]), (LAS unsigned*)(st_ + KNBUF + wave * 1024), 16, 0, 0); \
            __builtin_amdgcn_global_load_lds((const unsigned*)(VT + (size_t)tok0 + doff[3]), (LAS unsigned*)(st_ + KNBUF + KRBUF + wave * 1024), 16, 0, 0); \
            __builtin_amdgcn_global_load_lds((const unsigned*)(VT + (size_t)tok0 + doff[4]), (LAS unsigned*)(st_ + KNBUF + KRBUF + (wave + 8) * 1024), 16, 0, 0); } while (0)
        bf16x8 qf[2][6];
#pragma unroll
        for (int g = 0; g < 2; ++g)
#pragma unroll
            for (int kk = 0; kk < 6; ++kk) qf[g][kk] = *(const bf16x8*)(QB + (size_t)(qrow0 + wave * 32 + g * 16 + fr) * 1536 + head * 192 + kk * 32 + fq * 8);
        if (rnd < 4) {
            const float* rope = (const float*)(p.ws + OFF_ROPE);
#pragma unroll
            for (int g = 0; g < 2; ++g) { const int pos = (qrow0 + wave * 32 + g * 16 + fr) & 4095;
#pragma unroll
                for (int kk = 4; kk < 6; ++kk) { const int P = kk == 5 ? (pos & 63) : (pos >> 6); const float* cs = rope + (P * 16 + (fq & 1) * 8) * 2; const float sg = (fq & 2) ? 1.0f : -1.0f;
                    u32x4 mine = __builtin_bit_cast(u32x4, qf[g][kk]), res;
#pragma unroll
                    for (int e = 0; e < 4; ++e) { const unsigned pw = (unsigned)__shfl_xor((int)mine[e], 32); const f32x4 c4 = *(const f32x4*)(cs + 4 * e);
                        const float r0 = bf_lo(mine[e]) * c4[0] + sg * bf_lo(pw) * c4[1], r1 = bf_hi(mine[e]) * c4[2] + sg * bf_hi(pw) * c4[3]; res[e] = pk_bf16(r0, r1); }
                    qf[g][kk] = __builtin_bit_cast(bf16x8, res); } }
        }
        f32x4 o[2][8]; float mrow[2], lrow[2];
#pragma unroll
        for (int g = 0; g < 2; ++g) { mrow[g] = 0.f; lrow[g] = 0.f;
#pragma unroll
            for (int jb = 0; jb < 8; ++jb) o[g][jb] = (f32x4){0.f, 0.f, 0.f, 0.f}; }
        int okn[4], o8[2];
#pragma unroll
        for (int kk = 0; kk < 4; ++kk) okn[kk] = fr * KNROW + (((kk * 4 + fq) ^ fr) * 16);
#pragma unroll
        for (int j = 0; j < 2; ++j) o8[j] = fr * 128 + (((j * 4 + fq) ^ (fr >> 1)) * 16);
        ATT_DMA(t0, 0); asm volatile("s_waitcnt vmcnt(0)" ::: "memory"); __syncthreads();
        for (int t = t0; t < 68; ++t) { const int cur = (t - t0) & 1;
            if (t + 1 < 68) ATT_DMA(t + 1, cur ^ 1);
            const LAS unsigned char* kb = lds + cur * ATT_STAGE; const LAS unsigned char* rb = kb + KNBUF; const LAS unsigned char* vb = rb + KRBUF;
            f32x4 s[2][4];
            const f32x4 ci0 = {-mrow[0], -mrow[0], -mrow[0], -mrow[0]}, ci1 = {-mrow[1], -mrow[1], -mrow[1], -mrow[1]};
#pragma unroll
            for (int kt = 0; kt < 4; ++kt) { s[0][kt] = ci0; s[1][kt] = ci1;
#pragma unroll
                for (int kk = 0; kk < 6; ++kk) { const bf16x8 kf = kk < 4 ? *(const LAS bf16x8*)(kb + kt * 16 * KNROW + okn[kk & 3]) : *(const LAS bf16x8*)(rb + kt * 16 * KRROW + o8[kk & 1]);
                    s[0][kt] = __builtin_amdgcn_mfma_f32_16x16x32_bf16(kf, qf[0][kk], s[0][kt], 0, 0, 0);
                    s[1][kt] = __builtin_amdgcn_mfma_f32_16x16x32_bf16(kf, qf[1][kk], s[1][kt], 0, 0, 0); } }
            bf16x8 pf[2][2];
#pragma unroll
            for (int g = 0; g < 2; ++g) { float mx = -1e30f;
#pragma unroll
                for (int kt = 0; kt < 4; ++kt) mx = max3f(max3f(mx, s[g][kt][0], s[g][kt][1]), s[g][kt][2], s[g][kt][3]);
                mx = rows_max(mx);
                const bool grow = mx > 8.0f; const float dlt = grow ? mx : 0.f,
                alpha = __builtin_amdgcn_exp2f(-dlt); mrow[g] += dlt; float ls = 0.f;
                if (__builtin_amdgcn_ballot_w64(grow) != 0ull) {
#pragma unroll
                    for (int kt = 0; kt < 4; ++kt) s[g][kt] = s[g][kt] - dlt;
#pragma unroll
                    for (int jb = 0; jb < 8; ++jb) o[g][jb] *= alpha; }
#pragma unroll
                for (int kt = 0; kt < 4; ++kt)
#pragma unroll
                    for (int e = 0; e < 4; ++e) { s[g][kt][e] = __builtin_amdgcn_exp2f(s[g][kt][e]); ls += s[g][kt][e]; }
                lrow[g] = lrow[g] * alpha + ls;
#pragma unroll
                for (int kg = 0; kg < 2; ++kg) { u32x4 w; w.x = pk_bf16(s[g][2 * kg][0], s[g][2 * kg][1]); w.y = pk_bf16(s[g][2 * kg][2], s[g][2 * kg][3]);
                    w.z = pk_bf16(s[g][2 * kg + 1][0], s[g][2 * kg + 1][1]); w.w = pk_bf16(s[g][2 * kg + 1][2], s[g][2 * kg + 1][3]); pf[g][kg] = __builtin_bit_cast(bf16x8, w); } }
#pragma unroll
            for (int kg = 0; kg < 2; ++kg)
#pragma unroll
                for (int jb = 0; jb < 8; ++jb) { const bf16x8 vf = *(const LAS bf16x8*)(vb + jb * 16 * VROW + o8[kg]);
                    o[0][jb] = __builtin_amdgcn_mfma_f32_16x16x32_bf16(vf, pf[0][kg], o[0][jb], 0, 0, 0);
                    o[1][jb] = __builtin_amdgcn_mfma_f32_16x16x32_bf16(vf, pf[1][kg], o[1][jb], 0, 0, 0); }
            asm volatile("s_waitcnt vmcnt(0)" ::: "memory");
            __syncthreads();
        }
#undef ATT_DMA
#pragma unroll
        for (int g = 0; g < 2; ++g) { float lt = lrow[g]; lt += __shfl_xor(lt, 16); lt += __shfl_xor(lt, 32); const float inv = 1.0f / lt;
            bf16_t* op = AO + (size_t)(qrow0 + wave * 32 + g * 16 + fr) * D + head * 128 + 4 * fq;
#pragma unroll
            for (int jb = 0; jb < 8; ++jb) { const f32x4 v = o[g][jb] * inv; u32x2 w; w.x = pk_bf16(v[0], v[1]); w.y = pk_bf16(v[2], v[3]); *(u32x2*)(op + jb * 16) = w; } }
        __syncthreads();
    }
    __builtin_amdgcn_s_setprio(0);
}

__global__ void __launch_bounds__(512) fwd_megakernel(Params p) {
    extern __shared__ __attribute__((aligned(16))) unsigned char smem[];
    cg::grid_group grid = cg::this_grid();
    LAS unsigned char* lds = (LAS unsigned char*)smem;
    bf16_t* W = (bf16_t*)(p.ws + OFF_W); float* H = (float*)(p.ws + OFF_H); bf16_t* A = (bf16_t*)(p.ws + OFF_A); unsigned char* BIG = p.ws + OFF_BIG;
    float* PFFN = (float*)(BIG + 209715200); float* PHG = (float*)(BIG + T16); float* PMLA = (float*)(BIG + 314572800);
    const float* modall = (const float*)(p.ws + OFF_MOD); const float* rope = (const float*)(p.ws + OFF_ROPE);
    volatile LAS unsigned* xst = (volatile LAS unsigned*)(lds + LDS_MAIN);
    if (threadIdx.x < 4) xst[threadIdx.x] = 0u;
    __syncthreads();
    XcdBarrier xbar = xcd_barrier_post((unsigned*)(p.ws + OFF_BAR), xst);
    phase_prologue(p, smem, 0, 1, 0, true);
    convert_layer(p, smem, 0);
    grid.sync();
#define GRID_BAR() xcd_barrier(xbar)
#define RESID_NORM(KT, Aop, Wop, midx, coef, from_in, Pbuf, nlayer, gi, mbase, ctx_in, EXTRA_Y, EXTRA) do { \
        resid_latent<KT>(lds, p, Aop, Wop, H, modl, midx, coef, from_in); GRID_BAR(); \
        if (blockIdx.x < 32) resid_ctx<KT>(lds, Aop, Wop, Pbuf); else { phase_norm(p, nlayer, gi, mbase, 0, nullptr, 0, 0, 0.f, 0, 0, NLAT, 32); EXTRA_Y; } \
        GRID_BAR(); \
        phase_norm(p, nlayer, gi, mbase, 0, Pbuf, layer, midx, coef, ctx_in, NLAT, MTOK, 0); EXTRA; GRID_BAR(); } while (0)
    phase_norm(p, 0, 0, 0, 1, nullptr, 0, 0, 0.f, 0, 0, MTOK, 0);
    GRID_BAR();
    for (int layer = 0; layer < 4; ++layer) {
        const float* modl = modall + (size_t)layer * 9 * (NMOD * D); const int j = layer >> 1;
        { EpiGateUp e; e.hid = (bf16_t*)BIG; run_gemm(lds, A, W + W_GU0, MTOK, 2 * FH, D, e); }
        GRID_BAR();
        if (layer == 0) RESID_NORM(FH, (const bf16_t*)BIG, W + W_D0, 2, 0.5f, 1, PFFN, 0, 1, 3, 1, phase_prologue(p, smem, 1, 4, 32, false), (void)0);
        else RESID_NORM(FH, (const bf16_t*)BIG, W + W_D0, 2, 0.5f, 0, PFFN, layer, 1, 3, 0, (void)0, (void)0);
        if ((layer & 1) == 0) {
            { EpiHgIn e; e.base = (u16*)BIG; e.lb = (const float*)(p.ws + OFF_LB) + j * 2048; run_gemm(lds, A, W + W_IN, MTOK, 5120, D, e); }
            GRID_BAR();
            phase_scan(p, smem);
            GRID_BAR();
            phase_readout(p, j);
            GRID_BAR();
            RESID_NORM(D, (const bf16_t*)BIG, W + W_OUT, 5, 1.0f, 0, PHG, layer, 2, 6, 0, (void)0, (void)0);
        } else {
            bf16_t* QB = (bf16_t*)BIG; bf16_t* KN = QB + (size_t)MTOK * 1536; bf16_t* VT = KN + (size_t)MTOK * D; bf16_t* CQN = VT + (size_t)MTOK * D; bf16_t* CKVN = CQN + (size_t)MTOK * 384; bf16_t* KR = CKVN + (size_t)MTOK * 256;
            { EpiMlaDown e; e.dproj = (float*)BIG; e.kr = KR; e.rope = rope; run_gemm(lds, A, W + W_DN, MTOK, 768, D, e); }
            GRID_BAR();
            phase_mla_norm(p, j);
            GRID_BAR();
            { EpiBf16 e; e.o = QB; e.ldc = 1536; e.scale = QSCALE; run_gemm(lds, CQN, W + W_UQ, MTOK, 1536, 384, e); }
            { EpiBf16 e; e.o = KN; e.ldc = D; e.scale = 1.0f; run_gemm(lds, CKVN, W + W_K, MTOK, D, 256, e); }
            { EpiBf16 e; e.o = VT; e.ldc = MTOK; e.scale = 1.0f; run_gemm(lds, W + W_V, CKVN, D, MTOK, 256, e); }
            GRID_BAR();
            phase_attn(p, smem, layer != 3);
            GRID_BAR();
            if (layer != 3) RESID_NORM(D, A, W + W_O, 5, 1.0f, 0, PMLA, layer, 2, 6, 0, (void)0, (void)0);
            else { resid_latent<D>(lds, p, A, W + W_O, H, modl, 5, 1.0f, 0); GRID_BAR(); phase_norm(p, layer, 2, 6, 0, nullptr, 0, 0, 0.f, 0, 0, MTOK, 0); GRID_BAR(); }
        }
        { EpiGateUp e; e.hid = (bf16_t*)BIG; run_gemm(lds, A, W + W_GU1, layer == 3 ? NLAT : MTOK, 2 * FH, D, e); }
        GRID_BAR();
        if (layer != 3) RESID_NORM(FH, (const bf16_t*)BIG, W + W_D1, 8, 0.5f, 0, PFFN, layer + 1, 0, 0, 0, convert_layer(p, smem, layer + 1, 1, 32), convert_layer(p, smem, layer + 1, 2, 0));
        else { resid_latent<FH>(lds, p, (const bf16_t*)BIG, W + W_D1, H, modl, 8, 0.5f, 0); GRID_BAR(); }
    }
    phase_final(p);
}

extern "C" void kernel_launch(void* const* d_in, const int* in_sizes, int n_in, void* d_out, int out_size, void* d_ws, size_t ws_size, hipStream_t stream) {
    static int grid_blocks = 0;
    if (grid_blocks == 0) {
        if (n_in != 21 || out_size != NLAT * D || ws_size < WS_END) { fprintf(stderr, "kernel_launch: unexpected shapes (n_in %d out %d ws %zu need %zu)\n", n_in, out_size, ws_size, (size_t)WS_END); grid_blocks = -1; return; }
        int dev = 0, cus = 0, per_cu = 0;
        hipGetDevice(&dev); hipDeviceGetAttribute(&cus, hipDeviceAttributeMultiprocessorCount, dev);
        if (hipFuncSetAttribute((const void*)fwd_megakernel, hipFuncAttributeMaxDynamicSharedMemorySize, LDS_BYTES) != hipSuccess) { fprintf(stderr, "kernel_launch: hipFuncSetAttribute failed\n"); grid_blocks = -1; return; }
        hipOccupancyMaxActiveBlocksPerMultiprocessor(&per_cu, (const void*)fwd_megakernel, 512, LDS_BYTES);
        if (per_cu < 1) { fprintf(stderr, "kernel_launch: occupancy query says %d blocks per CU\n", per_cu); per_cu = 1; }
        (void)hipGetLastError();
        grid_blocks = cus;
    }
    if (grid_blocks < 0) return;
    if (hipMemsetAsync((unsigned char*)d_ws + OFF_BAR, 0, XCD_BAR_WORDS * 4, stream) != hipSuccess) { fprintf(stderr, "kernel_launch: memset failed\n"); return; }
    Params p{};
    const float** pp = (const float**)&p;
    for (int i = 0; i < 21; ++i) pp[i] = (const float*)d_in[i];
    p.out = (float*)d_out; p.ws = (unsigned char*)d_ws;
    void* args[] = {&p};
    hipError_t e = hipLaunchCooperativeKernel((const void*)fwd_megakernel, dim3(grid_blocks), dim3(512), args, LDS_BYTES, stream);
    if (e != hipSuccess) fprintf(stderr, "cooperative launch failed: %s (grid %d)\n", hipGetErrorString(e), grid_blocks);
}
```

```cpp
#include <hip/hip_runtime.h>
#include <hip/hip_cooperative_groups.h>
#include <cstdio>
namespace cg = cooperative_groups;
namespace pg8 {
#define PG8_LAS __attribute__((address_space(3)))
typedef unsigned short bf16_t;
typedef short bf16x8 __attribute__((ext_vector_type(8)));
typedef float f32x4 __attribute__((ext_vector_type(4)));
typedef unsigned u32x4 __attribute__((ext_vector_type(4)));
constexpr int BM = 256, BK = 64, HALF = 128, HTB = HALF * BK * 2  , STAGE_BYTES = 8 * HTB, NXCD = 8, WGM = 8;

__host__ __device__ __forceinline__ int lds_byte(int r, int c) { const int st = (r >> 4) * 2 + (c >> 5), rr = r & 15, cc = c & 31, ob = rr * 64 + cc * 2; return st * 1024 + (ob ^ (((ob >> 9) & 1) << 5)); }
__host__ __device__ __forceinline__ void stage_rc(int b, int& R, int& C) { const int st = b / 1024, sb = b % 1024, swz = sb ^ (((sb >> 9) & 1) << 5); R = (st >> 1) * 16 + swz / 64; C = (st & 1) * 32 + (swz % 64) / 2; }
__host__ __device__ __forceinline__ int perm32(int rho) { const int n = rho >> 4, i = rho & 15; return 8 * (i >> 2) + 4 * n + (i & 3); }

struct Unit { int pm, pn; };
struct Gemm { const bf16_t* A; const bf16_t* Bt; int M, N, K, ld; };

struct StaticOrder {
    int nM, nN, nwg, G, c;
    __host__ __device__ void init(int M, int N, int G_, int c_) { nM = M / BM; nN = N / BM; nwg = nM * nN; G = G_; c = c_; }
    __host__ __device__ bool next(int i, Unit& u) const {
        const long L = (long)i * G + c; if (L >= nwg) return false;
        int wgid = (int)L; { const int q = nwg / NXCD, r = nwg % NXCD, xcd = wgid % NXCD, off = wgid / NXCD; wgid = (xcd < r ? xcd * (q + 1) : r * (q + 1) + (xcd - r) * q) + off; }
        const int nig = WGM * nN, gid = wgid / nig, fm = gid * WGM, gsz = (nM - fm) < WGM ? (nM - fm) : WGM;
        u.pm = fm + ((wgid % nig) % gsz); u.pn = (wgid % nig) / gsz; return true;
    }
    __device__ __forceinline__ void a_ready(const Unit&) const {}
    __device__ __forceinline__ void done(const Unit&) const {}
};
__device__ __forceinline__ unsigned cvt_pk_bf16(float lo, float hi) { unsigned r; asm volatile("v_cvt_pk_bf16_f32 %0, %1, %2" : "=v"(r) : "v"(lo), "v"(hi)); return r; }
typedef float f32x2 __attribute__((ext_vector_type(2)));
template <class Epi, class Sched, bool STAMP = false>
__device__ __forceinline__ void gemm_phase(PG8_LAS unsigned char* lds, const Gemm g, const Sched& S, const Epi& E, unsigned long long* stamps) {
    int tid_ = threadIdx.x; asm volatile("" : "+v"(tid_)); const int tid = tid_, wid = __builtin_amdgcn_readfirstlane(tid >> 6), lane = tid & 63, wr = wid >> 2, wc = wid & 3, fr = lane & 15, fq = lane >> 4;
    const int K = g.K, nt = K / BK, LD = g.ld;
    int ts_lo = 0, ts_hi = 0, nts = 0; const unsigned long long rt_entry = STAMP ? (unsigned long long)wall_clock64() : 0ull;
#define PG8_STAMP() do { if (STAMP && wid == 0 && nts < 64) { const unsigned long long _c = (unsigned long long)clock64(); \
        ts_lo = (lane == nts) ? (int)(unsigned)_c : ts_lo; ts_hi = (lane == nts) ? (int)(unsigned)(_c >> 32) : ts_hi; ++nts; } } while (0)
    PG8_STAMP();
    unsigned voffA[2], voffB[2];
#pragma unroll
    for (int i = 0; i < 2; ++i) { int R, C; stage_rc(tid * 16 + i * 8192, R, C); const int Rb = Epi::PERM ? ((R & ~31) + perm32(R & 31)) : R;
        voffA[i] = (unsigned)(R * LD + C) * 2u; voffB[i] = (unsigned)(Rb * LD + C) * 2u; }
    const size_t kstep = (size_t)(BK * 2);
    const size_t hstep = (size_t)HALF * LD * 2;
    const size_t tstep = 2 * hstep;
    const unsigned ldsw = (unsigned)wid * 1024u;
    const int aoff = lds_byte(wr * 64 + fr, fq * 8), boff = lds_byte(wc * 32 + fr, fq * 8);
#define PG8_SA(b, h) (((b) * 2 + (h)) * HTB)
#define PG8_SB(b, h) ((4 + (b) * 2 + (h)) * HTB)
#define PG8_STAGE(bufoff, gbase, voff) do { _Pragma("unroll") for (int _i = 0; _i < 2; ++_i) \
        __builtin_amdgcn_global_load_lds((const unsigned*)((const char*)(gbase) + (voff)[_i]), (PG8_LAS unsigned*)(lds + (bufoff) + ldsw + _i * 8192), 16, 0, 0); } while (0)
#define PG8_LDA(dst, b, h) do { _Pragma("unroll") for (int m = 0; m < 4; ++m) _Pragma("unroll") for (int k = 0; k < 2; ++k) dst[m][k] = *(const PG8_LAS bf16x8*)(lds + PG8_SA(b, h) + aoff + m * 2048 + k * 1024); } while (0)
#define PG8_LDB(dst, b, h) do { _Pragma("unroll") for (int n = 0; n < 2; ++n) _Pragma("unroll") for (int k = 0; k < 2; ++k) dst[n][k] = *(const PG8_LAS bf16x8*)(lds + PG8_SB(b, h) + boff + n * 2048 + k * 1024); } while (0)
#define PG8_MMA(ai, bj, At, Bt) do { __builtin_amdgcn_s_setprio(1); _Pragma("unroll") for (int m = 0; m < 4; ++m) _Pragma("unroll") for (int n = 0; n < 2; ++n) _Pragma("unroll") for (int k = 0; k < 2; ++k) \
        acc[ai][bj][m][n] = __builtin_amdgcn_mfma_f32_16x16x32_bf16(Bt[n][k], At[m][k], acc[ai][bj][m][n], 0, 0, 0); __builtin_amdgcn_s_setprio(0); } while (0)
#define PG8_WAIT_V(n) asm volatile("s_waitcnt vmcnt(" #n ")" ::: "memory")
#define PG8_WAIT_L(n) asm volatile("s_waitcnt lgkmcnt(" #n ")" ::: "memory")
#define PG8_BAR __builtin_amdgcn_s_barrier()
#define PG8_SCHED __builtin_amdgcn_sched_barrier(0)
    Unit cur, nxt; int ui = 0;
    if (!S.next(0, cur)) return;
    f32x4 acc[2][2][4][2];
#pragma unroll
    for (int a = 0; a < 2; ++a)
#pragma unroll
        for (int b = 0; b < 2; ++b)
#pragma unroll
            for (int m = 0; m < 4; ++m)
#pragma unroll
                for (int n = 0; n < 2; ++n) acc[a][b][m][n] = (f32x4){0.f, 0.f, 0.f, 0.f};
    bf16x8 At[4][2], B0[2][2], B1[2][2];
    const char* cA = (const char*)g.A + (size_t)cur.pm * tstep; const char* cB = (const char*)g.Bt + (size_t)cur.pn * tstep;
    S.a_ready(cur);
    PG8_STAGE(PG8_SB(0, 0), cB, voffB); PG8_STAGE(PG8_SA(0, 0), cA, voffA); PG8_STAGE(PG8_SB(0, 1), cB + hstep, voffB); PG8_STAGE(PG8_SA(0, 1), cA + hstep, voffA);
    if (wr == 1) PG8_BAR;
    PG8_WAIT_V(4); PG8_BAR;
    PG8_STAGE(PG8_SB(1, 0), cB + kstep, voffB); PG8_STAGE(PG8_SA(1, 0), cA + kstep, voffA); PG8_STAGE(PG8_SB(1, 1), cB + hstep + kstep, voffB);
    PG8_WAIT_V(6); PG8_BAR;
    PG8_STAMP();
    for (;;) {
        const bool has_next = S.next(ui + 1, nxt);
        const char* nA = has_next ? (const char*)g.A + (size_t)nxt.pm * tstep : cA; const char* nB = has_next ? (const char*)g.Bt + (size_t)nxt.pn * tstep : cB;
        for (int t = 0; t < nt; t += 2) {
            const bool last = (t == nt - 2);
            const char* a1 = cA + (size_t)(t + 1) * kstep;
            const char* a2 = last ? nA : cA + (size_t)(t + 2) * kstep; const char* b2 = last ? nB : cB + (size_t)(t + 2) * kstep;
            const char* a3 = a2 + kstep; const char* b3 = b2 + kstep;
            if (last && has_next) S.a_ready(nxt);
            PG8_LDB(B0, 0, 0); PG8_SCHED; PG8_LDA(At, 0, 0); PG8_STAGE(PG8_SA(1, 1), a1 + hstep, voffA);
            PG8_WAIT_L(8); PG8_BAR; PG8_WAIT_L(0); PG8_MMA(0, 0, At, B0); PG8_BAR; PG8_SCHED;
            PG8_LDB(B1, 0, 1); PG8_STAGE(PG8_SB(0, 0), b2, voffB);
            PG8_BAR; PG8_WAIT_L(0); PG8_MMA(0, 1, At, B1); PG8_BAR;
            PG8_LDA(At, 0, 1); PG8_STAGE(PG8_SA(0, 0), a2, voffA);
            PG8_BAR; PG8_WAIT_L(0); PG8_MMA(1, 0, At, B0); PG8_BAR; PG8_SCHED;
            PG8_STAGE(PG8_SB(0, 1), b2 + hstep, voffB);
            PG8_WAIT_V(6); PG8_BAR; PG8_MMA(1, 1, At, B1); PG8_BAR;
            PG8_LDB(B0, 1, 0); PG8_SCHED; PG8_LDA(At, 1, 0); PG8_STAGE(PG8_SA(0, 1), a2 + hstep, voffA);
            PG8_WAIT_L(8); PG8_BAR; PG8_WAIT_L(0); PG8_MMA(0, 0, At, B0); PG8_BAR; PG8_SCHED;
            PG8_LDB(B1, 1, 1); PG8_STAGE(PG8_SB(1, 0), b3, voffB);
            PG8_BAR; PG8_WAIT_L(0); PG8_MMA(0, 1, At, B1); PG8_BAR;
            PG8_LDA(At, 1, 1); PG8_STAGE(PG8_SA(1, 0), a3, voffA);
            PG8_BAR; PG8_WAIT_L(0); PG8_MMA(1, 0, At, B0); PG8_BAR; PG8_SCHED;
            PG8_STAGE(PG8_SB(1, 1), b3 + hstep, voffB);
            PG8_WAIT_V(6); PG8_BAR; PG8_MMA(1, 1, At, B1); PG8_BAR;
        }
        PG8_STAMP();
        if constexpr (!Epi::AFTER_DRAIN) { E(acc, cur, wr, wc, fr, fq); S.done(cur); }
        PG8_STAMP();
        if (!has_next) break;
#pragma unroll
        for (int a = 0; a < 2; ++a)
#pragma unroll
            for (int b = 0; b < 2; ++b)
#pragma unroll
                for (int m = 0; m < 4; ++m)
#pragma unroll
                    for (int n = 0; n < 2; ++n) acc[a][b][m][n] = (f32x4){0.f, 0.f, 0.f, 0.f};
        cur = nxt; cA = nA; cB = nB; ++ui;
    }
    PG8_WAIT_V(0);
    if (wr == 0) PG8_BAR;
    PG8_BAR;
    if constexpr (Epi::AFTER_DRAIN) { E.fused(acc, cur, wr, wc, fr, fq, lds, wid, lane); S.done(cur); }
    PG8_STAMP();
    if (STAMP && wid == 0) { stamps[lane] = lane < nts ? (((unsigned long long)(unsigned)ts_hi << 32) | (unsigned)ts_lo) : 0ull;
        if (lane == 62) stamps[62] = rt_entry; if (lane == 63) stamps[63] = (unsigned long long)wall_clock64(); }
#undef PG8_STAMP
#undef PG8_SA
#undef PG8_SB
#undef PG8_STAGE
#undef PG8_LDA
#undef PG8_LDB
#undef PG8_MMA
#undef PG8_WAIT_V
#undef PG8_WAIT_L
#undef PG8_BAR
#undef PG8_SCHED
}
}

typedef pg8::bf16_t bf16_t;
typedef pg8::bf16x8 bf16x8;
typedef pg8::f32x4 f32x4;
typedef unsigned short u16;
typedef unsigned u32x2 __attribute__((ext_vector_type(2)));
typedef unsigned u32x4 __attribute__((ext_vector_type(4)));
typedef float f32x2 __attribute__((ext_vector_type(2)));
#define LAS __attribute__((address_space(3)))

constexpr int D = 1024, NLAT = 32768, NCTX = 2048, MTOK = 34816, SEQ = 4096, CTXL = 256, FH = 2816, NMOD = 9;
constexpr int LDS_MAIN = 157696, LDS_BYTES = LDS_MAIN + 16;
constexpr size_t OFF_MOD = 4096, OFF_LB = 1331200, OFF_ROPE = 1347584, OFF_BAR = 1355776, OFF_W = 2097152, OFF_H = 50331648, OFF_A = 192937984, OFF_BIG = 264241152;
constexpr size_t T16 = 71303168;
constexpr size_t WS_END = OFF_BIG + 5 * T16;
constexpr size_t W_GU0 = 0, W_D0 = 5767168, W_GU1 = 8650752, W_D1 = 14417920, W_MIX = 17301504;
constexpr size_t W_IN = W_MIX, W_OUT = W_MIX + 5242880;
constexpr size_t W_DN = W_MIX, W_UQ = W_MIX + 786432, W_K = W_MIX + 1376256, W_V = W_MIX + 1638400, W_O = W_MIX + 1900544;
constexpr float QSCALE = 0.07216878364870322f * 1.4426950408889634f;

struct Params {
    const float *x, *c, *ctx, *c_ctx, *mod_w, *mod_b, *norm_g, *w_gate, *w_up, *w_down, *hg_w_in, *hg_w_out, *hg_gn, *hg_lb, *mla_w_down, *mla_q_norm, *mla_w_uq, *mla_kv_norm, *mla_w_ukv, *mla_w_o, *final_g;
    float* out; unsigned char* ws;
};

__device__ __forceinline__ int fresh_tid() { int t = threadIdx.x; asm volatile("" : "+v"(t)); return t; }
__device__ __forceinline__ unsigned pk_bf16(float lo, float hi) { unsigned r; asm volatile("v_cvt_pk_bf16_f32 %0, %1, %2" : "=v"(r) : "v"(lo), "v"(hi)); return r; }
__device__ __forceinline__ float bf_lo(unsigned w) { return __uint_as_float(w << 16); }
__device__ __forceinline__ float bf_hi(unsigned w) { return __uint_as_float(w & 0xffff0000u); }
__device__ __forceinline__ float sigmoidf_(float x) { return __builtin_amdgcn_rcpf(1.0f + __expf(-x)); }
__device__ __forceinline__ float siluf_(float x) { return x * sigmoidf_(x); }
__device__ __forceinline__ float rows_max(float v) {
    u32x2 a = __builtin_amdgcn_permlane32_swap(__float_as_uint(v), __float_as_uint(v), false, false); v = fmaxf(__uint_as_float(a.x), __uint_as_float(a.y));
    u32x2 b = __builtin_amdgcn_permlane16_swap(__float_as_uint(v), __float_as_uint(v), false, false); return fmaxf(__uint_as_float(b.x), __uint_as_float(b.y)); }
__device__ __forceinline__ float max3f(float a, float b, float c) { float r; asm("v_max3_f32 %0, %1, %2, %3" : "=v"(r) : "v"(a), "v"(b), "v"(c)); return r; }
__device__ __forceinline__ float wave_sum(float v) {
#pragma unroll
    for (int o = 1; o < 64; o <<= 1) v += __shfl_xor(v, o);
    return v;
}
__device__ __forceinline__ const float* in_row(const Params& p, int row) { return row < NLAT ? p.x + (size_t)row * D : p.ctx + (size_t)(row - NLAT) * D; }
__device__ __forceinline__ int mod_row(int row) { return row < NLAT ? (row >> 12) : 8; }


#define XB_TMO      128
#define XB_XCNT(j)  (256  + 64 * (j))
#define XB_XSUB(j)  (1280 + 64 * (j))
#define XB_XGEN(j)  (2304 + 64 * (j))
#define XB_TOP      3328
#define XB_TOPGEN   3392
#define XCD_BAR_WORDS 3456
#define XB_SPIN_CAP (1u << 22)
__device__ __forceinline__ unsigned xb_ld(unsigned* p)              { return __hip_atomic_load(p, __ATOMIC_RELAXED, __HIP_MEMORY_SCOPE_AGENT); }
__device__ __forceinline__ unsigned xb_add(unsigned* p, unsigned v) { return __hip_atomic_fetch_add(p, v, __ATOMIC_RELAXED, __HIP_MEMORY_SCOPE_AGENT); }
__device__ __forceinline__ unsigned xb_xcc_id() { return (unsigned)__builtin_amdgcn_s_getreg((3 << 11) | 20) & 0xFu; }
#define XB_SPIN(cond, bar) do { unsigned _sp = 0; while (cond) { __builtin_amdgcn_s_sleep(1); \
    if ((++_sp & 255u) == 0u) { if (xb_ld(&(bar)[XB_TMO])) break; if (_sp > XB_SPIN_CAP) { atomicAdd(&(bar)[XB_TMO], 1u); break; } } } } while (0)
struct XcdBarrier { unsigned* bar; unsigned x; volatile LAS unsigned* st; };
__device__ __forceinline__ XcdBarrier xcd_barrier_post(unsigned* bar, volatile LAS unsigned* st) {
    XcdBarrier b; b.bar = bar; b.x = xb_xcc_id(); b.st = st;
    if (threadIdx.x == 0) (void)xb_add(&bar[XB_XCNT(b.x)], 1u);
    return b;
}
__device__ __forceinline__ void xcd_barrier_complete(unsigned* bar, unsigned x, unsigned& nloc, unsigned& nx) {
    const unsigned G = gridDim.x * gridDim.y * gridDim.z;
    unsigned sum, cnt, mine, sp = 0u;
    for (;;) {
        sum = 0u; cnt = 0u; mine = 0u;
#pragma unroll
        for (unsigned j = 0; j < 16; ++j) { const unsigned c = xb_ld(&bar[XB_XCNT(j)]); sum += c; cnt += (c > 0u) ? 1u : 0u; mine = (j == x) ? c : mine; }
        if (sum == G) break;
        __builtin_amdgcn_s_sleep(1);
        if ((++sp & 255u) == 0u) { if (xb_ld(&bar[XB_TMO])) break; if (sp > XB_SPIN_CAP) { atomicAdd(&bar[XB_TMO], 1u); break; } }
    }
    nloc = mine > 0u ? mine : 1u; nx = cnt > 0u ? cnt : 1u;
}
__device__ __forceinline__ void xcd_barrier(const XcdBarrier& b) {
    asm volatile("s_waitcnt vmcnt(0)" ::: "memory");
    __syncthreads();
    if (threadIdx.x == 0) {
        unsigned* bar = b.bar;
        __builtin_amdgcn_s_waitcnt(0);
        unsigned nloc = b.st[0], nx = b.st[1];
        if (nloc == 0u) { xcd_barrier_complete(bar, b.x, nloc, nx); b.st[0] = nloc; b.st[1] = nx; }
        const unsigned old = xb_add(&bar[XB_XSUB(b.x)], 1u);
        const unsigned gen = old / nloc;
        if (old + 1u == (gen + 1u) * nloc) {
            __builtin_amdgcn_fence(__ATOMIC_RELEASE, "agent");
            asm volatile("s_waitcnt vmcnt(0)" ::: "memory");
            const unsigned og = xb_add(&bar[XB_TOP], 1u);
            const unsigned tg = og / nx;
            if (og + 1u == (tg + 1u) * nx) xb_add(&bar[XB_TOPGEN], 1u);
            else XB_SPIN(xb_ld(&bar[XB_TOPGEN]) == tg, bar);
            __builtin_amdgcn_fence(__ATOMIC_ACQUIRE, "agent");
            xb_add(&bar[XB_XGEN(b.x)], 1u);
            asm volatile("s_waitcnt vmcnt(0)" ::: "memory");
        } else {
            XB_SPIN(xb_ld(&bar[XB_XGEN(b.x)]) == gen, bar);
            __builtin_amdgcn_fence(__ATOMIC_ACQUIRE, "agent");
            asm volatile("s_waitcnt vmcnt(0)" ::: "memory");
        }
    }
    __syncthreads();
}

#define EPI_ARGS const f32x4 (&acc)[2][2][4][2], const pg8::Unit& u, int wr, int wc, int fr, int fq
struct EpiGateUp {
    static constexpr bool PERM = false, AFTER_DRAIN = false; bf16_t* hid;
    __device__ __forceinline__ void operator()(EPI_ARGS) const {
        const int row0 = u.pm * 256 + wr * 64 + fr, hc0 = u.pn * 128 + wc * 16 + 4 * fq;
#pragma unroll
        for (int ai = 0; ai < 2; ++ai)
#pragma unroll
            for (int m = 0; m < 4; ++m) { bf16_t* rp = hid + (size_t)(row0 + ai * 128 + m * 16) * FH + hc0;
#pragma unroll
                for (int bj = 0; bj < 2; ++bj) { const f32x4 g = acc[ai][bj][m][0], up = acc[ai][bj][m][1];
                    u32x2 w; w.x = pk_bf16(siluf_(g[0]) * up[0], siluf_(g[1]) * up[1]); w.y = pk_bf16(siluf_(g[2]) * up[2], siluf_(g[3]) * up[3]);
                    *(u32x2*)(rp + bj * 64) = w; } }
    }
};
struct EpiResid {
    static constexpr bool PERM = false, AFTER_DRAIN = false; const float* x; const float* ctx; float* H; const float* modl; int midx; float coef; int from_input; int row_off;
    __device__ __forceinline__ void operator()(EPI_ARGS) const {
        const int row0 = u.pm * 256 + wr * 64 + fr, col0 = u.pn * 256 + wc * 32 + 4 * fq;
        const float* mv = modl + (size_t)mod_row(u.pm * 256) * (NMOD * D) + midx * D + col0;
        f32x4 mm[2][2];
#pragma unroll
        for (int bj = 0; bj < 2; ++bj)
#pragma unroll
            for (int n = 0; n < 2; ++n) mm[bj][n] = *(const f32x4*)(mv + bj * 128 + n * 16) * coef;
#pragma unroll
        for (int ai = 0; ai < 2; ++ai)
#pragma unroll
            for (int m = 0; m < 4; ++m) { const int row = row0 + ai * 128 + m * 16;
                const float* sp = (from_input ? (row < NLAT ? x + (size_t)row * D : ctx + (size_t)(row - NLAT) * D) : H + (size_t)row * D) + col0; float* dp = H + (size_t)row * D + col0;
#pragma unroll
                for (int bj = 0; bj < 2; ++bj)
#pragma unroll
                    for (int n = 0; n < 2; ++n) { const f32x4 s = *(const f32x4*)(sp + bj * 128 + n * 16); *(f32x4*)(dp + bj * 128 + n * 16) = s + mm[bj][n] * acc[ai][bj][m][n]; }
                asm volatile("" ::: "memory"); }
    }
};
struct EpiF32Part {
    static constexpr bool PERM = false, AFTER_DRAIN = false; float* P;
    __device__ __forceinline__ void operator()(EPI_ARGS) const {
        const int row0 = u.pm * 256 + wr * 64 + fr, col0 = u.pn * 256 + wc * 32 + 4 * fq;
#pragma unroll
        for (int ai = 0; ai < 2; ++ai)
#pragma unroll
            for (int m = 0; m < 4; ++m) { float* dp = P + (size_t)(row0 + ai * 128 + m * 16) * D + col0;
#pragma unroll
                for (int bj = 0; bj < 2; ++bj)
#pragma unroll
                    for (int n = 0; n < 2; ++n) *(f32x4*)(dp + bj * 128 + n * 16) = acc[ai][bj][m][n]; }
    }
};
struct EpiHgIn {
    static constexpr bool PERM = false, AFTER_DRAIN = false; u16* base; const float* lb;
    __device__ __forceinline__ void operator()(EPI_ARGS) const {
        const int kind = u.pn >> 2; const int row0 = u.pm * 256 + wr * 64 + fr, col0 = (u.pn & 3) * 256 + wc * 32 + 4 * fq;
        u16* dst = base + (size_t)kind * (T16 / 2);
        if (kind == 1 || kind == 2) {
            f32x4 l4[2][2], s4[2][2];
#pragma unroll
            for (int bj = 0; bj < 2; ++bj)
#pragma unroll
                for (int n = 0; n < 2; ++n) { l4[bj][n] = *(const f32x4*)(lb + (kind - 1) * D + col0 + bj * 128 + n * 16); s4[bj][n] = (1.0f - l4[bj][n]) * 65535.0f; l4[bj][n] = l4[bj][n] * 65535.0f + 0.5f; }
#pragma unroll
            for (int ai = 0; ai < 2; ++ai)
#pragma unroll
                for (int m = 0; m < 4; ++m) { u16* rp = dst + (size_t)(row0 + ai * 128 + m * 16) * D + col0;
#pragma unroll
                    for (int bj = 0; bj < 2; ++bj)
#pragma unroll
                        for (int n = 0; n < 2; ++n) { const f32x4 v = acc[ai][bj][m][n]; unsigned q[4];
#pragma unroll
                            for (int e = 0; e < 4; ++e) q[e] = (unsigned)(l4[bj][n][e] + s4[bj][n][e] * sigmoidf_(v[e]));
                            u32x2 w; w.x = q[0] | (q[1] << 16); w.y = q[2] | (q[3] << 16); *(u32x2*)(rp + bj * 128 + n * 16) = w; } }
        } else {
#pragma unroll
            for (int ai = 0; ai < 2; ++ai)
#pragma unroll
                for (int m = 0; m < 4; ++m) { u16* rp = dst + (size_t)(row0 + ai * 128 + m * 16) * D + col0;
#pragma unroll
                    for (int bj = 0; bj < 2; ++bj)
#pragma unroll
                        for (int n = 0; n < 2; ++n) { const f32x4 v = acc[ai][bj][m][n]; u32x2 w;
                            if (kind == 4) { w.x = pk_bf16(siluf_(v[0]), siluf_(v[1])); w.y = pk_bf16(siluf_(v[2]), siluf_(v[3])); }
                            else { w.x = pk_bf16(v[0], v[1]); w.y = pk_bf16(v[2], v[3]); }
                            *(u32x2*)(rp + bj * 128 + n * 16) = w; } }
        }
    }
};
struct EpiMlaDown {
    static constexpr bool PERM = false, AFTER_DRAIN = false; float* dproj; bf16_t* kr; const float* rope;
    __device__ __forceinline__ void operator()(EPI_ARGS) const {
        const int row0 = u.pm * 256 + wr * 64 + fr;
#pragma unroll
        for (int bj = 0; bj < 2; ++bj) { const int gcol = u.pn * 256 + bj * 128 + wc * 32;
            if (gcol < 640) {
#pragma unroll
                for (int ai = 0; ai < 2; ++ai)
#pragma unroll
                    for (int m = 0; m < 4; ++m) { float* rp = dproj + (size_t)(row0 + ai * 128 + m * 16) * 640 + gcol + 4 * fq;
                        *(f32x4*)rp = acc[ai][bj][m][0]; *(f32x4*)(rp + 16) = acc[ai][bj][m][1]; }
            } else if (gcol < 704) { const int axis = (gcol - 640) >> 5;
#pragma unroll
                for (int ai = 0; ai < 2; ++ai)
#pragma unroll
                    for (int m = 0; m < 4; ++m) { const int row = row0 + ai * 128 + m * 16; f32x4 a = acc[ai][bj][m][0], b = acc[ai][bj][m][1];
                        if (row < NLAT) { const int pos = row & 4095, P = axis ? (pos & 63) : (pos >> 6); const float* cs = rope + (P * 16 + 4 * fq) * 2;
                            const f32x4 c0 = *(const f32x4*)cs, c1 = *(const f32x4*)(cs + 4);
                            const f32x4 cv = {c0[0], c0[2], c1[0], c1[2]}, sv = {c0[1], c0[3], c1[1], c1[3]};
                            const f32x4 na = a * cv - b * sv, nb = a * sv + b * cv; a = na; b = nb; }
                        bf16_t* rp = kr + (size_t)row * 64 + axis * 32 + 4 * fq; u32x2 w;
                        w.x = pk_bf16(a[0], a[1]); w.y = pk_bf16(a[2], a[3]); *(u32x2*)rp = w;
                        w.x = pk_bf16(b[0], b[1]); w.y = pk_bf16(b[2], b[3]); *(u32x2*)(rp + 16) = w; asm volatile("" ::: "memory"); }
            }
        }
    }
};
struct EpiBf16 {
    static constexpr bool PERM = false, AFTER_DRAIN = false; bf16_t* o; size_t ldc; float scale;
    __device__ __forceinline__ void operator()(EPI_ARGS) const {
        const int row0 = u.pm * 256 + wr * 64 + fr, col0 = u.pn * 256 + wc * 32 + 4 * fq;
#pragma unroll
        for (int ai = 0; ai < 2; ++ai)
#pragma unroll
            for (int m = 0; m < 4; ++m) { bf16_t* rp = o + (size_t)(row0 + ai * 128 + m * 16) * ldc + col0;
#pragma unroll
                for (int bj = 0; bj < 2; ++bj)
#pragma unroll
                    for (int n = 0; n < 2; ++n) { const f32x4 v = acc[ai][bj][m][n] * scale; u32x2 w; w.x = pk_bf16(v[0], v[1]); w.y = pk_bf16(v[2], v[3]); *(u32x2*)(rp + bj * 128 + n * 16) = w; } }
    }
};
template <class Epi> __device__ __forceinline__ void run_gemm(LAS unsigned char* lds, const bf16_t* A, const bf16_t* Bt, int M, int N, int K, const Epi& E, int ld = 0, int rot = 0) {
    pg8::Gemm g; g.A = A; g.Bt = Bt; g.M = M; g.N = N; g.K = K; g.ld = ld ? ld : K;
    pg8::StaticOrder S; S.init(M, N, gridDim.x, (blockIdx.x + gridDim.x - rot) % gridDim.x);
    pg8::gemm_phase<Epi, pg8::StaticOrder, false>(lds, g, S, E, nullptr);
}
template <int KTOT> __device__ __forceinline__ void resid_latent(LAS unsigned char* lds, const Params& p, const bf16_t* A, const bf16_t* Wt, float* H, const float* modl, int midx, float coef, int from_input) {
    EpiResid e; e.x = p.x; e.ctx = p.ctx; e.H = H; e.modl = modl; e.midx = midx; e.coef = coef; e.from_input = from_input; e.row_off = 0; run_gemm(lds, A, Wt, NLAT, D, KTOT, e);
}
template <int KTOT> __device__ __forceinline__ void resid_ctx(LAS unsigned char* lds, const bf16_t* A, const bf16_t* Wt, float* P) {
    EpiF32Part e; e.P = P; run_gemm(lds, A + (size_t)NLAT * KTOT, Wt, NCTX, D, KTOT, e, KTOT, 0);
}

__device__ __forceinline__ const float* conv_src(int kind, const float* s0, const float* s1, int R) {
    switch (kind) {
        case 1: return ((R >> 4) & 1 ? s1 : s0) + (R >> 5) * 16 + (R & 15);
        case 2: return s0 + (R >> 7) * 256 + (R & 127);
        case 3: return s0 + (R >> 7) * 256 + 128 + (R & 127);
        case 4: return R < 704 ? s0 + R : nullptr;
        default: return s0 + R;
    }
}
__device__ __forceinline__ void conv_T(unsigned char* smem, int kind, const float* s0, const float* s1, int ldn, int Ndst, int K, bf16_t* dst, int rot, int wg_lo = 0) {
    float* tile = (float*)smem;
    const int tid = fresh_tid(), nkb = K / 64, ntiles = (Ndst / 64) * nkb, G = (int)gridDim.x - wg_lo;
    for (int t = ((int)blockIdx.x - wg_lo + rot) % G; t < ntiles; t += G) {
        const int R0 = (t / nkb) * 64, k0 = (t % nkb) * 64;
        { const int Rl = tid & 63, kr = tid >> 6; const float* sp = conv_src(kind, s0, s1, R0 + Rl);
#pragma unroll
            for (int ps = 0; ps < 8; ++ps) { const int kl = ps * 8 + kr; tile[Rl * 65 + kl] = sp ? sp[(size_t)(k0 + kl) * ldn] : 0.f; } }
        __syncthreads();
        { const int Rl = tid >> 3, c = tid & 7; const float* s = tile + Rl * 65 + 8 * c; u32x4 w;
            w.x = pk_bf16(s[0], s[1]); w.y = pk_bf16(s[2], s[3]); w.z = pk_bf16(s[4], s[5]); w.w = pk_bf16(s[6], s[7]);
            *(u32x4*)(dst + (size_t)(R0 + Rl) * K + k0 + 8 * c) = w; }
        __syncthreads();
    }
}
__device__ __forceinline__ void convert_layer(const Params& p, unsigned char* smem, int layer, int part = 3, int wg_lo = 0) {
    bf16_t* W = (bf16_t*)(p.ws + OFF_W);
    for (int s = 0; s < 2; ++s) {
        const size_t o = ((size_t)layer * 2 + s) * D * FH;
        if (part & 1) conv_T(smem, 1, p.w_gate + o, p.w_up + o, FH, 2 * FH, D, W + (s ? W_GU1 : W_GU0), s * 64, wg_lo);
        if (part & (s ? 2 : 1)) conv_T(smem, 0, p.w_down + o, nullptr, D, D, FH, W + (s ? W_D1 : W_D0), s * 64 + 32, wg_lo);
    }
    if (!(part & 1)) return;
    const int j = layer >> 1;
    if ((layer & 1) == 0) {
        conv_T(smem, 0, p.hg_w_in + (size_t)j * D * 5120, nullptr, 5120, 5120, D, W + W_IN, 128, wg_lo);
        conv_T(smem, 0, p.hg_w_out + (size_t)j * D * D, nullptr, D, D, D, W + W_OUT, 160, wg_lo);
    } else {
        conv_T(smem, 4, p.mla_w_down + (size_t)j * D * 704, nullptr, 704, 768, D, W + W_DN, 128, wg_lo);
        conv_T(smem, 0, p.mla_w_uq + (size_t)j * 384 * 1536, nullptr, 1536, 1536, 384, W + W_UQ, 176, wg_lo);
        conv_T(smem, 2, p.mla_w_ukv + (size_t)j * 256 * 2048, nullptr, 2048, 1024, 256, W + W_K, 200, wg_lo);
        conv_T(smem, 3, p.mla_w_ukv + (size_t)j * 256 * 2048, nullptr, 2048, 1024, 256, W + W_V, 216, wg_lo);
        conv_T(smem, 0, p.mla_w_o + (size_t)j * D * D, nullptr, D, D, D, W + W_O, 232, wg_lo);
    }
}
__device__ __forceinline__ void phase_prologue(const Params& p, unsigned char* smem, int l0, int l1, int wg_lo, bool tables) {
    float* sS = (float*)smem;
    float* sP = sS + 9 * 1024;
    const int tid = fresh_tid(), wave = tid >> 6, lane = tid & 63;
    for (int i = tid; i < 9 * 1024; i += 512) { const float v = i < 8192 ? p.c[i] : p.c_ctx[i - 8192]; sS[i] = siluf_(v); }
    __syncthreads();
    float* mod = (float*)(p.ws + OFF_MOD);
    for (int item = (int)blockIdx.x - wg_lo; item < (l1 - l0) * 144; item += (int)gridDim.x - wg_lo) {
        const int l = l0 + item / 144, j0 = (item % 144) * 64; const float* wp = p.mod_w + (size_t)l * D * (NMOD * D) + j0 + lane;
        float a[9];
#pragma unroll
        for (int r = 0; r < 9; ++r) a[r] = 0.f;
#pragma unroll 8
        for (int kk = 0; kk < 128; ++kk) { const int k = wave * 128 + kk; const float w = wp[(size_t)k * (NMOD * D)];
#pragma unroll
            for (int r = 0; r < 9; ++r) a[r] += sS[r * 1024 + k] * w; }
#pragma unroll
        for (int r = 0; r < 9; ++r) sP[(wave * 9 + r) * 64 + lane] = a[r];
        __syncthreads();
        for (int i = tid; i < 9 * 64; i += 512) { const int r = i >> 6, jl = i & 63; float s = p.mod_b[(size_t)l * (NMOD * D) + j0 + jl];
#pragma unroll
            for (int w = 0; w < 8; ++w) s += sP[(w * 9 + r) * 64 + jl];
            mod[((size_t)l * 9 + r) * (NMOD * D) + j0 + jl] = s; }
        __syncthreads();
    }
    if (!tables) return;
    const int gt = blockIdx.x * 512 + tid;
    if (gt < 4096) { float* lb = (float*)(p.ws + OFF_LB); const int idx = gt & 2047;
        if (gt < 2048) lb[gt] = 0.f; else lb[gt] = sigmoidf_(p.hg_lb[2048 + idx] - p.hg_lb[idx]); }
    if (gt >= 4096 && gt < 4096 + 1024) { float* rt = (float*)(p.ws + OFF_ROPE); const int i = gt - 4096, P = i >> 4, j = i & 15;
        const float inv = exp2f(-(float)j * (13.287712379549449f / 16.0f)); const float xa = (float)P * inv;
        const float kq = __builtin_rintf(xa * 0.15915494309189535f); float r = fmaf(-kq, 6.28125f, xa); r = fmaf(-kq, 1.9353071795864769e-3f, r);
        rt[2 * i] = cosf(r); rt[2 * i + 1] = sinf(r); }
}
__device__ __forceinline__ void phase_norm(const Params& p, int layer, int gi, int mbase, int from_input, const float* P, int player, int pmidx, float pcoef, int ctx_from_input, int row_lo, int row_hi, int wg_lo) {
    const int tid = fresh_tid(); const int lane = tid & 63, gw = ((int)blockIdx.x - wg_lo) * 8 + (tid >> 6), nw = ((int)gridDim.x - wg_lo) * 8;
    const float* H = (const float*)(p.ws + OFF_H); bf16_t* A = (bf16_t*)(p.ws + OFF_A);
    const float* modl = (const float*)(p.ws + OFF_MOD) + (size_t)layer * 9 * (NMOD * D); const float* g = p.norm_g + ((size_t)layer * 3 + gi) * D;
    const int chunk = (row_hi - row_lo + nw - 1) / nw; const int r0 = row_lo + gw * chunk, r1 = (r0 + chunk < row_hi) ? r0 + chunk : row_hi;
    f32x4 gs[4], sh[4]; int cur_mr = -1;
    for (int row = r0; row < r1; ++row) {
        const float* hp = (from_input || (ctx_from_input && row >= NLAT)) ? in_row(p, row) : H + (size_t)row * D;
        const int mrow_i = mod_row(row);
        if (mrow_i != cur_mr) { cur_mr = mrow_i; const float* mr = modl + (size_t)mrow_i * (NMOD * D) + mbase * D;
#pragma unroll
            for (int j = 0; j < 4; ++j) { const int c = 4 * lane + 256 * j; gs[j] = *(const f32x4*)(g + c) * (*(const f32x4*)(mr + D + c) + 1.0f); sh[j] = *(const f32x4*)(mr + c); } }
        f32x4 v[4]; float s = 0.f;
#pragma unroll
        for (int j = 0; j < 4; ++j) v[j] = *(const f32x4*)(hp + 4 * lane + 256 * j);
        if (P != nullptr && row >= NLAT) {
            const float* pr = P + (size_t)(row - NLAT) * D; const float* pm = (const float*)(p.ws + OFF_MOD) + ((size_t)player * 9 + 8) * (NMOD * D) + pmidx * D; float* hw = (float*)(p.ws + OFF_H) + (size_t)row * D;
#pragma unroll
            for (int j = 0; j < 4; ++j) { const int c = 4 * lane + 256 * j; const f32x4 t = *(const f32x4*)(pr + c);
                v[j] = v[j] + (*(const f32x4*)(pm + c) * pcoef) * t; *(f32x4*)(hw + c) = v[j]; }
        }
#pragma unroll
        for (int j = 0; j < 4; ++j) s += (v[j][0] * v[j][0] + v[j][1] * v[j][1]) + (v[j][2] * v[j][2] + v[j][3] * v[j][3]);
        const float rstd = __builtin_amdgcn_rsqf(wave_sum(s) * (1.0f / D) + 1e-6f);
#pragma unroll
        for (int j = 0; j < 4; ++j) { const int c = 4 * lane + 256 * j;
            const f32x4 y = (v[j] * rstd) * gs[j] + sh[j]; u32x2 w; w.x = pk_bf16(y[0], y[1]); w.y = pk_bf16(y[2], y[3]); *(u32x2*)(A + (size_t)row * D + c) = w; }
    }
}
__device__ __forceinline__ void phase_final(const Params& p) {
    const int tid = fresh_tid(); const int lane = tid & 63, gw = blockIdx.x * 8 + (tid >> 6), nw = gridDim.x * 8; const float* H = (const float*)(p.ws + OFF_H);
    for (int row = gw; row < NLAT; row += nw) { const float* hp = H + (size_t)row * D; f32x4 v[4]; float s = 0.f;
#pragma unroll
        for (int j = 0; j < 4; ++j) { v[j] = *(const f32x4*)(hp + 4 * lane + 256 * j); s += (v[j][0] * v[j][0] + v[j][1] * v[j][1]) + (v[j][2] * v[j][2] + v[j][3] * v[j][3]); }
        const float rstd = __builtin_amdgcn_rsqf(wave_sum(s) * (1.0f / D) + 1e-6f);
#pragma unroll
        for (int j = 0; j < 4; ++j) { const int c = 4 * lane + 256 * j; *(f32x4*)(p.out + (size_t)row * D + c) = v[j] * rstd * *(const f32x4*)(p.final_g + c); } }
}
__device__ __forceinline__ void phase_readout(const Params& p, int j) {
    const int tid = fresh_tid(); const int lane = tid & 63, gw = blockIdx.x * 8 + (tid >> 6), nw = gridDim.x * 8;
    const bf16_t* O = (const bf16_t*)(p.ws + OFF_A); const bf16_t* SG = (const bf16_t*)(p.ws + OFF_BIG + 4 * T16); bf16_t* R = (bf16_t*)(p.ws + OFF_BIG);
    const float* gn = p.hg_gn + (size_t)j * 128 + (lane & 7) * 16;
    for (int row = gw; row < MTOK; row += nw) { const size_t off = (size_t)row * D + 16 * lane;
        const u32x4 o0 = *(const u32x4*)(O + off), o1 = *(const u32x4*)(O + off + 8), g0 = *(const u32x4*)(SG + off), g1 = *(const u32x4*)(SG + off + 8);
        float ov[16], gv[16];
#pragma unroll
        for (int e = 0; e < 4; ++e) { ov[2 * e] = bf_lo(o0[e]); ov[2 * e + 1] = bf_hi(o0[e]); ov[8 + 2 * e] = bf_lo(o1[e]); ov[9 + 2 * e] = bf_hi(o1[e]);
            gv[2 * e] = bf_lo(g0[e]); gv[2 * e + 1] = bf_hi(g0[e]); gv[8 + 2 * e] = bf_lo(g1[e]); gv[9 + 2 * e] = bf_hi(g1[e]); }
        float s = 0.f;
#pragma unroll
        for (int e = 0; e < 16; ++e) s += ov[e] * ov[e];
        s += __shfl_xor(s, 1); s += __shfl_xor(s, 2); s += __shfl_xor(s, 4);
        const float rstd = __builtin_amdgcn_rsqf(s * (1.0f / 128.0f) + 1e-6f); u32x4 w0, w1;
#pragma unroll
        for (int e = 0; e < 4; ++e) { w0[e] = pk_bf16(ov[2 * e] * rstd * gn[2 * e] * gv[2 * e], ov[2 * e + 1] * rstd * gn[2 * e + 1] * gv[2 * e + 1]);
            w1[e] = pk_bf16(ov[8 + 2 * e] * rstd * gn[8 + 2 * e] * gv[8 + 2 * e], ov[9 + 2 * e] * rstd * gn[9 + 2 * e] * gv[9 + 2 * e]); }
        *(u32x4*)(R + off) = w0; *(u32x4*)(R + off + 8) = w1; }
}
__device__ __forceinline__ void phase_mla_norm(const Params& p, int j) {
    const int tid = fresh_tid(); const int lane = tid & 63, gw = blockIdx.x * 8 + (tid >> 6), nw = gridDim.x * 8;
    const float* DP = (const float*)(p.ws + OFF_BIG); bf16_t* CQN = (bf16_t*)(p.ws + OFF_BIG + 106954752 + 2 * T16); bf16_t* CKVN = CQN + (size_t)MTOK * 384;
    const float* qn = p.mla_q_norm + (size_t)j * 384; const float* kn = p.mla_kv_norm + (size_t)j * 256;
    for (int row = gw; row < MTOK; row += nw) { const float* dp = DP + (size_t)row * 640;
        f32x2 a[3]; float s = 0.f;
#pragma unroll
        for (int t = 0; t < 3; ++t) { a[t] = *(const f32x2*)(dp + 2 * lane + 128 * t); s += a[t][0] * a[t][0] + a[t][1] * a[t][1]; }
        const f32x4 b = *(const f32x4*)(dp + 384 + 4 * lane); const float s2 = (b[0] * b[0] + b[1] * b[1]) + (b[2] * b[2] + b[3] * b[3]);
        const float r1 = __builtin_amdgcn_rsqf(wave_sum(s) * (1.0f / 384.0f) + 1e-6f), r2 = __builtin_amdgcn_rsqf(wave_sum(s2) * (1.0f / 256.0f) + 1e-6f);
#pragma unroll
        for (int t = 0; t < 3; ++t) { const int c = 2 * lane + 128 * t; *(unsigned*)(CQN + (size_t)row * 384 + c) = pk_bf16(a[t][0] * r1 * qn[c], a[t][1] * r1 * qn[c + 1]); }
        { const int c = 4 * lane; u32x2 w; w.x = pk_bf16(b[0] * r2 * kn[c], b[1] * r2 * kn[c + 1]); w.y = pk_bf16(b[2] * r2 * kn[c + 2], b[3] * r2 * kn[c + 3]); *(u32x2*)(CKVN + (size_t)row * 256 + c) = w; } }
}

__device__ __forceinline__ float dpp_xor1(float v) { return __int_as_float(__builtin_amdgcn_update_dpp(0, __float_as_int(v), 0xB1, 0xF, 0xF, true)); }
__device__ __forceinline__ float dpp_xor2(float v) { return __int_as_float(__builtin_amdgcn_update_dpp(0, __float_as_int(v), 0x4E, 0xF, 0xF, true)); }
__device__ __forceinline__ float dpp_hmir(float v) { return __int_as_float(__builtin_amdgcn_update_dpp(0, __float_as_int(v), 0x141, 0xF, 0xF, true)); }
constexpr int SNB = 272;
__device__ __forceinline__ int scan_block(int dir, int i) { return dir == 0 ? i : (i < 16 ? 15 - i : 287 - i); }
__device__ __forceinline__ int scan_row(int b, int X, int tt) { return X < 16 ? NLAT + b * CTXL + X * 16 + tt : b * SEQ + (X - 16) * 16 + tt; }
__device__ __forceinline__ void phase_scan(const Params& p, unsigned char* smem) {
    float* sF = (float*)smem;
    float* sQ = sF + 2 * 2 * 16 * 128;
    float* sV = sQ + 2 * 2 * 16 * 128;
    float* sVN = sV + 2 * 2 * 16 * 32;
    float* sPO = sVN + 3 * 2 * 16 * 32;
    float* sQS = sPO + 2 * 2 * 16 * 8 * 32;
    const u16* QH = (const u16*)(p.ws + OFF_BIG); const u16* FF = QH + T16 / 2; const u16* FB = FF + T16 / 2; const u16* VI = FB + T16 / 2; bf16_t* O = (bf16_t*)(p.ws + OFF_A);
    const int tid = fresh_tid(), wave = __builtin_amdgcn_readfirstlane(tid >> 6), lane = tid & 63;
    for (int task = blockIdx.x; task < 256; task += gridDim.x) {
        const int b = task >> 5, h = (task >> 2) & 7, vq = task & 3;
        if (wave < 4) {
            const int dir = wave >> 1, khalf = wave & 1, ksub = lane & 7, vg = lane >> 3, kbase = khalf * 64 + ksub * 8;
            f32x2 S2[8][2];
            { const u32x2 w0 = *(const u32x2*)(VI + (size_t)scan_row(b, scan_block(dir, 0), dir ? 15 : 0) * D + h * 128 + vq * 32 + 4 * vg);
              const f32x2 iA = {-bf_lo(w0.x), -bf_hi(w0.x)}, iB = {-bf_lo(w0.y), -bf_hi(w0.y)};
#pragma unroll
              for (int e = 0; e < 8; ++e) { S2[e][0] = iA; S2[e][1] = iB; } }
            __syncthreads();
            for (int it = 0; it < SNB; ++it) { const int buf = it & 1;
                const float* bF = sF + (buf * 2 + dir) * 16 * 128 + kbase; const float* bQ = sQ + (buf * 2 + dir) * 16 * 128 + kbase; const float* bV = sV + (buf * 2 + dir) * 16 * 32 + 4 * vg;
                float* bP = sPO + ((buf * 2 + dir) * 16 * 8 + khalf * 4 + (ksub >> 1)) * 32 + 4 * vg;
#define SC_LD(X, s_) do { const int tt_ = dir ? 15 - (s_) : (s_); X##f0 = *(const f32x4*)(bF + tt_ * 128); X##f1 = *(const f32x4*)(bF + tt_ * 128 + 4); \
                    X##q0 = *(const f32x4*)(bQ + tt_ * 128); X##q1 = *(const f32x4*)(bQ + tt_ * 128 + 4); X##vv = *(const f32x4*)(bV + tt_ * 32); } while (0)
#define SC_STEP(X, s_) do { const int tt_ = dir ? 15 - (s_) : (s_); f32x2 oA = {0.f, 0.f}, oB = {0.f, 0.f}; const f32x2 vA = {X##vv[0], X##vv[1]}, vB = {X##vv[2], X##vv[3]}; \
                    _Pragma("unroll") for (int k = 0; k < 8; ++k) { const float f = k < 4 ? X##f0[k & 3] : X##f1[k & 3], q = k < 4 ? X##q0[k & 3] : X##q1[k & 3]; const f32x2 fb = {f, f}, qb = {q, q}; \
                        S2[k][0] = __builtin_elementwise_fma(fb, S2[k][0], vA); S2[k][1] = __builtin_elementwise_fma(fb, S2[k][1], vB); \
                        oA = __builtin_elementwise_fma(S2[k][0], qb, oA); oB = __builtin_elementwise_fma(S2[k][1], qb, oB); } \
                    f32x4 o = {oA[0], oA[1], oB[0], oB[1]}; \
                    _Pragma("unroll") for (int e = 0; e < 4; ++e) { o[e] += dpp_xor1(o[e]); } \
                    *(f32x4*)(bP + tt_ * 256) = o; } while (0)
                f32x4 Af0, Af1, Aq0, Aq1, Avv, Bf0, Bf1, Bq0, Bq1, Bvv;
                SC_LD(A, 0);
#pragma unroll
                for (int s = 0; s < 16; s += 2) { SC_LD(B, s + 1); SC_STEP(A, s); SC_LD(A, (s + 2 < 16 ? s + 2 : 15)); SC_STEP(B, s + 1); }
#undef SC_LD
#undef SC_STEP
                __syncthreads();
            }
            __syncthreads();
        } else {
            const int ht = tid - 256, stt = ht >> 4, sc = ht & 15, vdir = ht >> 6, vtt = (ht & 63) >> 2, vc = ht & 3, ftt = ht >> 3, fv4 = ht & 7;
            u32x4 rf[2], rq[2], rv, rvn;
#define SC_GLOAD(it_) do { _Pragma("unroll") for (int d = 0; d < 2; ++d) { const size_t ro = (size_t)scan_row(b, scan_block(d, (it_)), stt) * D + h * 128 + 8 * sc; \
                rf[d] = *(const u32x4*)((d ? FB : FF) + ro); rq[d] = *(const u32x4*)(QH + ro); } \
                if (ht < 128) { rv = *(const u32x4*)(VI + (size_t)scan_row(b, scan_block(vdir, (it_)), vtt) * D + h * 128 + vq * 32 + 8 * vc); \
                    const int s_ = vdir ? 15 - vtt : vtt; const bool inblk = s_ < 15; const int nit = inblk ? (it_) : (it_) + 1; const int ntt = inblk ? (vdir ? vtt - 1 : vtt + 1) : (vdir ? 15 : 0); \
                    rvn = (u32x4){0u, 0u, 0u, 0u}; if (nit < SNB) rvn = *(const u32x4*)(VI + (size_t)scan_row(b, scan_block(vdir, nit), ntt) * D + h * 128 + vq * 32 + 8 * vc); } } while (0)
#define SC_LSTORE(buf_, ring_) do { _Pragma("unroll") for (int d = 0; d < 2; ++d) { float* fp = sF + (((buf_) * 2 + d) * 16 + stt) * 128 + 8 * sc; float* qp = sQ + (((buf_) * 2 + d) * 16 + stt) * 128 + 8 * sc; f32x4 a0, a1, b0, b1; \
                a0[0] = (float)(rf[d][0] & 0xffffu); a0[1] = (float)(rf[d][0] >> 16); a0[2] = (float)(rf[d][1] & 0xffffu); a0[3] = (float)(rf[d][1] >> 16); \
                a1[0] = (float)(rf[d][2] & 0xffffu); a1[1] = (float)(rf[d][2] >> 16); a1[2] = (float)(rf[d][3] & 0xffffu); a1[3] = (float)(rf[d][3] >> 16); \
                b0[0] = bf_lo(rq[d][0]); b0[1] = bf_hi(rq[d][0]); b0[2] = bf_lo(rq[d][1]); b0[3] = bf_hi(rq[d][1]); b1[0] = bf_lo(rq[d][2]); b1[1] = bf_hi(rq[d][2]); b1[2] = bf_lo(rq[d][3]); b1[3] = bf_hi(rq[d][3]); \
                *(f32x4*)fp = a0 * (1.0f / 65535.0f); *(f32x4*)(fp + 4) = a1 * (1.0f / 65535.0f); *(f32x4*)qp = b0; *(f32x4*)(qp + 4) = b1; \
                sQS[(((ring_) * 2 + d) * 16 + stt) * 16 + sc] = ((b0[0] + b0[1]) + (b0[2] + b0[3])) + ((b1[0] + b1[1]) + (b1[2] + b1[3])); } \
                if (ht < 128) { float* vp = sV + (((buf_) * 2 + vdir) * 16 + vtt) * 32 + 8 * vc; float* np = sVN + (((ring_) * 2 + vdir) * 16 + vtt) * 32 + 8 * vc; f32x4 c0, c1, n0, n1; \
                    c0[0] = bf_lo(rv[0]); c0[1] = bf_hi(rv[0]); c0[2] = bf_lo(rv[1]); c0[3] = bf_hi(rv[1]); c1[0] = bf_lo(rv[2]); c1[1] = bf_hi(rv[2]); c1[2] = bf_lo(rv[3]); c1[3] = bf_hi(rv[3]); \
                    n0[0] = bf_lo(rvn[0]); n0[1] = bf_hi(rvn[0]); n0[2] = bf_lo(rvn[1]); n0[3] = bf_hi(rvn[1]); n1[0] = bf_lo(rvn[2]); n1[1] = bf_hi(rvn[2]); n1[2] = bf_lo(rvn[3]); n1[3] = bf_hi(rvn[3]); \
                    *(f32x4*)vp = c0 - n0; *(f32x4*)(vp + 4) = c1 - n1; *(f32x4*)np = n0; *(f32x4*)(np + 4) = n1; } } while (0)
#define SC_FINAL(it_) do { if (ht < 128) { const int fb_ = (it_) & 1; u32x2 pv[2]; bf16_t* op[2]; bool rmw[2]; \
                _Pragma("unroll") for (int d = 0; d < 2; ++d) { const int X = scan_block(d, (it_)); const int other = d == 0 ? (X < 16 ? 15 - X : 287 - X) : X; rmw[d] = (it_) > other; \
                    op[d] = O + (size_t)scan_row(b, X, ftt) * D + h * 128 + vq * 32 + 4 * fv4; if (rmw[d]) pv[d] = *(const u32x2*)op[d]; } \
                _Pragma("unroll") for (int d = 0; d < 2; ++d) { const float* pp = sPO + ((fb_ * 2 + d) * 16 + ftt) * 256 + 4 * fv4; f32x4 o = ((*(const f32x4*)pp + *(const f32x4*)(pp + 32)) + (*(const f32x4*)(pp + 64) + *(const f32x4*)(pp + 96))) + ((*(const f32x4*)(pp + 128) + *(const f32x4*)(pp + 160)) + (*(const f32x4*)(pp + 192) + *(const f32x4*)(pp + 224))); \
                    { const int rg_ = (it_) % 3; const float* qsp = sQS + ((rg_ * 2 + d) * 16 + ftt) * 16; const f32x4 c4 = (*(const f32x4*)qsp + *(const f32x4*)(qsp + 4)) + (*(const f32x4*)(qsp + 8) + *(const f32x4*)(qsp + 12)); \
                      const float ct = (c4[0] + c4[1]) + (c4[2] + c4[3]); o = o + ct * *(const f32x4*)(sVN + ((rg_ * 2 + d) * 16 + ftt) * 32 + 4 * fv4); }     \
                    if (rmw[d]) { o[0] += bf_lo(pv[d].x); o[1] += bf_hi(pv[d].x); o[2] += bf_lo(pv[d].y); o[3] += bf_hi(pv[d].y); } \
                    u32x2 w; w.x = pk_bf16(o[0], o[1]); w.y = pk_bf16(o[2], o[3]); *(u32x2*)op[d] = w; } } } while (0)
            SC_GLOAD(0); SC_LSTORE(0, 0); SC_GLOAD(1);
            __syncthreads();
            for (int it = 0; it < SNB; ++it) {
                if (it + 1 < SNB) SC_LSTORE((it + 1) & 1, (it + 1) % 3);
                if (it + 2 < SNB) SC_GLOAD(it + 2);
                if (it > 0) SC_FINAL(it - 1);
                __syncthreads();
            }
            SC_FINAL(SNB - 1);
            __syncthreads();
#undef SC_GLOAD
#undef SC_LSTORE
#undef SC_FINAL
        }
    }
}

constexpr int KNROW = 256, KRROW = 128, VROW = 128, KNBUF = 64 * KNROW, KRBUF = 64 * KRROW, VBUF = 128 * VROW, ATT_STAGE = KNBUF + KRBUF + VBUF;
__device__ __forceinline__ void phase_attn(const Params& p, unsigned char* smem, bool with_ctx) {
    const bf16_t* QB = (const bf16_t*)(p.ws + OFF_BIG); const bf16_t* KN = QB + (size_t)MTOK * 1536; const bf16_t* VT = KN + (size_t)MTOK * D;
    const bf16_t* KR = VT + (size_t)MTOK * D + (size_t)MTOK * 384 + (size_t)MTOK * 256; bf16_t* AO = (bf16_t*)(p.ws + OFF_A);
    LAS unsigned char* lds = (LAS unsigned char*)smem;
    const int tid = fresh_tid(), wave = __builtin_amdgcn_readfirstlane(tid >> 6), lane = tid & 63, fr = lane & 15, fq = lane >> 4;
    const int nrounds = with_ctx ? 5 : 4; const int xcd = blockIdx.x & 7, jx = blockIdx.x >> 3;
    if (wave >= 4) __builtin_amdgcn_s_setprio(1);
    for (int rnd = 0; rnd < nrounds; ++rnd) {
        int b, head, qrow0, t0;
        if (rnd < 4) { const int grp = xcd * 8 + rnd * 2 + (jx >> 4); b = grp >> 3; head = grp & 7; qrow0 = b * SEQ + (jx & 15) * 256; t0 = 0; }
        else { if (blockIdx.x >= 64) break; b = blockIdx.x >> 3; head = blockIdx.x & 7; qrow0 = NLAT + b * CTXL; t0 = 64; }
        unsigned doff[5];
#pragma unroll
        for (int i = 0; i < 2; ++i) { const int ci = 64 * (wave + 8 * i) + lane, rho = ci >> 4, c = (ci & 15) ^ (rho & 15), ii = rho & 15, key = (rho & 32) + 8 * (ii >> 2) + 4 * ((rho >> 4) & 1) + (ii & 3);
            doff[i] = (unsigned)(key * D + head * 128 + 8 * c); }
        { const int ci = 64 * wave + lane, rho = ci >> 3, c = (ci & 7) ^ ((rho >> 1) & 7), ii = rho & 15, key = (rho & 32) + 8 * (ii >> 2) + 4 * ((rho >> 4) & 1) + (ii & 3); doff[2] = (unsigned)(key * 64 + 8 * c); }
#pragma unroll
        for (int i = 0; i < 2; ++i) { const int ci = 64 * (wave + 8 * i) + lane, vcol = ci >> 3, c = (ci & 7) ^ ((vcol >> 1) & 7); doff[3 + i] = (unsigned)((head * 128 + vcol) * MTOK + 8 * c); }
#define ATT_DMA(t, buf) do { const int tok0 = (t) < 64 ? b * SEQ + (t) * 64 : NLAT + b * CTXL + ((t) - 64) * 64; LAS unsigned char* st_ = lds + (buf) * ATT_STAGE; \
            __builtin_amdgcn_global_load_lds((const unsigned*)(KN + (size_t)tok0 * D + doff[0]), (LAS unsigned*)(st_ + wave * 1024), 16, 0, 0); \
            __builtin_amdgcn_global_load_lds((const unsigned*)(KN + (size_t)tok0 * D + doff[1]), (LAS unsigned*)(st_ + (wave + 8) * 1024), 16, 0, 0); \
            __builtin_amdgcn_global_load_lds((const unsigned*)(KR + (size_t)tok0 * 64 + doff[2]), (LAS unsigned*)(st_ + KNBUF + wave * 1024), 16, 0, 0); \
            __builtin_amdgcn_global_load_lds((const unsigned*)(VT + (size_t)tok0 + doff[3]), (LAS unsigned*)(st_ + KNBUF + KRBUF + wave * 1024), 16, 0, 0); \
            __builtin_amdgcn_global_load_lds((const unsigned*)(VT + (size_t)tok0 + doff[4]), (LAS unsigned*)(st_ + KNBUF + KRBUF + (wave + 8) * 1024), 16, 0, 0); } while (0)
        bf16x8 qf[2][6];
#pragma unroll
        for (int g = 0; g < 2; ++g)
#pragma unroll
            for (int kk = 0; kk < 6; ++kk) qf[g][kk] = *(const bf16x8*)(QB + (size_t)(qrow0 + wave * 32 + g * 16 + fr) * 1536 + head * 192 + kk * 32 + fq * 8);
        if (rnd < 4) {
            const float* rope = (const float*)(p.ws + OFF_ROPE);
#pragma unroll
            for (int g = 0; g < 2; ++g) { const int pos = (qrow0 + wave * 32 + g * 16 + fr) & 4095;
#pragma unroll
                for (int kk = 4; kk < 6; ++kk) { const int P = kk == 5 ? (pos & 63) : (pos >> 6); const float* cs = rope + (P * 16 + (fq & 1) * 8) * 2; const float sg = (fq & 2) ? 1.0f : -1.0f;
                    u32x4 mine = __builtin_bit_cast(u32x4, qf[g][kk]), res;
#pragma unroll
                    for (int e = 0; e < 4; ++e) { const unsigned pw = (unsigned)__shfl_xor((int)mine[e], 32); const f32x4 c4 = *(const f32x4*)(cs + 4 * e);
                        const float r0 = bf_lo(mine[e]) * c4[0] + sg * bf_lo(pw) * c4[1], r1 = bf_hi(mine[e]) * c4[2] + sg * bf_hi(pw) * c4[3]; res[e] = pk_bf16(r0, r1); }
                    qf[g][kk] = __builtin_bit_cast(bf16x8, res); } }
        }
        f32x4 o[2][8]; float mrow[2], lrow[2];
#pragma unroll
        for (int g = 0; g < 2; ++g) { mrow[g] = 0.f; lrow[g] = 0.f;
#pragma unroll
            for (int jb = 0; jb < 8; ++jb) o[g][jb] = (f32x4){0.f, 0.f, 0.f, 0.f}; }
        int okn[4], o8[2];
#pragma unroll
        for (int kk = 0; kk < 4; ++kk) okn[kk] = fr * KNROW + (((kk * 4 + fq) ^ fr) * 16);
#pragma unroll
        for (int j = 0; j < 2; ++j) o8[j] = fr * 128 + (((j * 4 + fq) ^ (fr >> 1)) * 16);
        ATT_DMA(t0, 0); asm volatile("s_waitcnt vmcnt(0)" ::: "memory"); __syncthreads();
        for (int t = t0; t < 68; ++t) { const int cur = (t - t0) & 1;
            if (t + 1 < 68) ATT_DMA(t + 1, cur ^ 1);
            const LAS unsigned char* kb = lds + cur * ATT_STAGE; const LAS unsigned char* rb = kb + KNBUF; const LAS unsigned char* vb = rb + KRBUF;
            f32x4 s[2][4];
            const f32x4 ci0 = {-mrow[0], -mrow[0], -mrow[0], -mrow[0]}, ci1 = {-mrow[1], -mrow[1], -mrow[1], -mrow[1]};
#pragma unroll
            for (int kt = 0; kt < 4; ++kt) { s[0][kt] = ci0; s[1][kt] = ci1;
#pragma unroll
                for (int kk = 0; kk < 6; ++kk) { const bf16x8 kf = kk < 4 ? *(const LAS bf16x8*)(kb + kt * 16 * KNROW + okn[kk & 3]) : *(const LAS bf16x8*)(rb + kt * 16 * KRROW + o8[kk & 1]);
                    s[0][kt] = __builtin_amdgcn_mfma_f32_16x16x32_bf16(kf, qf[0][kk], s[0][kt], 0, 0, 0);
                    s[1][kt] = __builtin_amdgcn_mfma_f32_16x16x32_bf16(kf, qf[1][kk], s[1][kt], 0, 0, 0); } }
            bf16x8 pf[2][2];
#pragma unroll
            for (int g = 0; g < 2; ++g) { float mx = -1e30f;
#pragma unroll
                for (int kt = 0; kt < 4; ++kt) mx = max3f(max3f(mx, s[g][kt][0], s[g][kt][1]), s[g][kt][2], s[g][kt][3]);
                float ls = 0.f;
                if (__builtin_amdgcn_ballot_w64(mx > 8.0f) != 0ull) {
                    mx = rows_max(mx);
                    const float dlt = mx > 8.0f ? mx : 0.f, alpha = __builtin_amdgcn_exp2f(-dlt); mrow[g] += dlt; lrow[g] *= alpha;
#pragma unroll
                    for (int kt = 0; kt < 4; ++kt) s[g][kt] = s[g][kt] - dlt;
#pragma unroll
                    for (int jb = 0; jb < 8; ++jb) o[g][jb] *= alpha; }
#pragma unroll
                for (int kt = 0; kt < 4; ++kt)
#pragma unroll
                    for (int e = 0; e < 4; ++e) { s[g][kt][e] = __builtin_amdgcn_exp2f(s[g][kt][e]); ls += s[g][kt][e]; }
                lrow[g] += ls;
#pragma unroll
                for (int kg = 0; kg < 2; ++kg) { u32x4 w; w.x = pk_bf16(s[g][2 * kg][0], s[g][2 * kg][1]); w.y = pk_bf16(s[g][2 * kg][2], s[g][2 * kg][3]);
                    w.z = pk_bf16(s[g][2 * kg + 1][0], s[g][2 * kg + 1][1]); w.w = pk_bf16(s[g][2 * kg + 1][2], s[g][2 * kg + 1][3]); pf[g][kg] = __builtin_bit_cast(bf16x8, w); } }
#pragma unroll
            for (int kg = 0; kg < 2; ++kg)
#pragma unroll
                for (int jb = 0; jb < 8; ++jb) { const bf16x8 vf = *(const LAS bf16x8*)(vb + jb * 16 * VROW + o8[kg]);
                    o[0][jb] = __builtin_amdgcn_mfma_f32_16x16x32_bf16(vf, pf[0][kg], o[0][jb], 0, 0, 0);
                    o[1][jb] = __builtin_amdgcn_mfma_f32_16x16x32_bf16(vf, pf[1][kg], o[1][jb], 0, 0, 0); }
            asm volatile("s_waitcnt vmcnt(0)" ::: "memory");
            __syncthreads();
        }
#undef ATT_DMA
#pragma unroll
        for (int g = 0; g < 2; ++g) { float lt = lrow[g]; lt += __shfl_xor(lt, 16); lt += __shfl_xor(lt, 32); const float inv = 1.0f / lt;
            bf16_t* op = AO + (size_t)(qrow0 + wave * 32 + g * 16 + fr) * D + head * 128 + 4 * fq;
#pragma unroll
            for (int jb = 0; jb < 8; ++jb) { const f32x4 v = o[g][jb] * inv; u32x2 w; w.x = pk_bf16(v[0], v[1]); w.y = pk_bf16(v[2], v[3]); *(u32x2*)(op + jb * 16) = w; } }
        __syncthreads();
    }
    __builtin_amdgcn_s_setprio(0);
}

__global__ void __launch_bounds__(512) fwd_megakernel(Params p) {
    extern __shared__ __attribute__((aligned(16))) unsigned char smem[];
    cg::grid_group grid = cg::this_grid();
    LAS unsigned char* lds = (LAS unsigned char*)smem;
    bf16_t* W = (bf16_t*)(p.ws + OFF_W); float* H = (float*)(p.ws + OFF_H); bf16_t* A = (bf16_t*)(p.ws + OFF_A); unsigned char* BIG = p.ws + OFF_BIG;
    float* PFFN = (float*)(BIG + 209715200); float* PHG = (float*)(BIG + T16); float* PMLA = (float*)(BIG + 314572800);
    const float* modall = (const float*)(p.ws + OFF_MOD); const float* rope = (const float*)(p.ws + OFF_ROPE);
    volatile LAS unsigned* xst = (volatile LAS unsigned*)(lds + LDS_MAIN);
    if (threadIdx.x < 4) xst[threadIdx.x] = 0u;
    __syncthreads();
    XcdBarrier xbar = xcd_barrier_post((unsigned*)(p.ws + OFF_BAR), xst);
    phase_prologue(p, smem, 0, 1, 0, true);
    convert_layer(p, smem, 0);
    grid.sync();
#define GRID_BAR() xcd_barrier(xbar)
#define RESID_NORM(KT, Aop, Wop, midx, coef, from_in, Pbuf, nlayer, gi, mbase, ctx_in, EXTRA_Y, EXTRA) do { \
        resid_latent<KT>(lds, p, Aop, Wop, H, modl, midx, coef, from_in); GRID_BAR(); \
        if (blockIdx.x < 32) resid_ctx<KT>(lds, Aop, Wop, Pbuf); else { phase_norm(p, nlayer, gi, mbase, 0, nullptr, 0, 0, 0.f, 0, 0, NLAT, 32); EXTRA_Y; } \
        GRID_BAR(); \
        phase_norm(p, nlayer, gi, mbase, 0, Pbuf, layer, midx, coef, ctx_in, NLAT, MTOK, 0); EXTRA; GRID_BAR(); } while (0)
    phase_norm(p, 0, 0, 0, 1, nullptr, 0, 0, 0.f, 0, 0, MTOK, 0);
    GRID_BAR();
    for (int layer = 0; layer < 4; ++layer) {
        const float* modl = modall + (size_t)layer * 9 * (NMOD * D); const int j = layer >> 1;
        { EpiGateUp e; e.hid = (bf16_t*)BIG; run_gemm(lds, A, W + W_GU0, MTOK, 2 * FH, D, e); }
        GRID_BAR();
        if (layer == 0) RESID_NORM(FH, (const bf16_t*)BIG, W + W_D0, 2, 0.5f, 1, PFFN, 0, 1, 3, 1, phase_prologue(p, smem, 1, 4, 32, false), (void)0);
        else RESID_NORM(FH, (const bf16_t*)BIG, W + W_D0, 2, 0.5f, 0, PFFN, layer, 1, 3, 0, (void)0, (void)0);
        if ((layer & 1) == 0) {
            { EpiHgIn e; e.base = (u16*)BIG; e.lb = (const float*)(p.ws + OFF_LB) + j * 2048; run_gemm(lds, A, W + W_IN, MTOK, 5120, D, e); }
            GRID_BAR();
            phase_scan(p, smem);
            GRID_BAR();
            phase_readout(p, j);
            GRID_BAR();
            RESID_NORM(D, (const bf16_t*)BIG, W + W_OUT, 5, 1.0f, 0, PHG, layer, 2, 6, 0, (void)0, (void)0);
        } else {
            bf16_t* QB = (bf16_t*)BIG; bf16_t* KN = QB + (size_t)MTOK * 1536; bf16_t* VT = KN + (size_t)MTOK * D; bf16_t* CQN = VT + (size_t)MTOK * D; bf16_t* CKVN = CQN + (size_t)MTOK * 384; bf16_t* KR = CKVN + (size_t)MTOK * 256;
            { EpiMlaDown e; e.dproj = (float*)BIG; e.kr = KR; e.rope = rope; run_gemm(lds, A, W + W_DN, MTOK, 768, D, e); }
            GRID_BAR();
            phase_mla_norm(p, j);
            GRID_BAR();
            { EpiBf16 e; e.o = QB; e.ldc = 1536; e.scale = QSCALE; run_gemm(lds, CQN, W + W_UQ, MTOK, 1536, 384, e); }
            { EpiBf16 e; e.o = KN; e.ldc = D; e.scale = 1.0f; run_gemm(lds, CKVN, W + W_K, MTOK, D, 256, e); }
            { EpiBf16 e; e.o = VT; e.ldc = MTOK; e.scale = 1.0f; run_gemm(lds, W + W_V, CKVN, D, MTOK, 256, e); }
            GRID_BAR();
            phase_attn(p, smem, layer != 3);
            GRID_BAR();
            if (layer != 3) RESID_NORM(D, A, W + W_O, 5, 1.0f, 0, PMLA, layer, 2, 6, 0, (void)0, (void)0);
            else { resid_latent<D>(lds, p, A, W + W_O, H, modl, 5, 1.0f, 0); GRID_BAR(); phase_norm(p, layer, 2, 6, 0, nullptr, 0, 0, 0.f, 0, 0, MTOK, 0); GRID_BAR(); }
        }
        { EpiGateUp e; e.hid = (bf16_t*)BIG; run_gemm(lds, A, W + W_GU1, layer == 3 ? NLAT : MTOK, 2 * FH, D, e); }
        GRID_BAR();
        if (layer != 3) RESID_NORM(FH, (const bf16_t*)BIG, W + W_D1, 8, 0.5f, 0, PFFN, layer + 1, 0, 0, 0, convert_layer(p, smem, layer + 1, 1, 32), convert_layer(p, smem, layer + 1, 2, 0));
        else { resid_latent<FH>(lds, p, (const bf16_t*)BIG, W + W_D1, H, modl, 8, 0.5f, 0); GRID_BAR(); }
    }
    phase_final(p);
}

extern "C" void kernel_launch(void* const* d_in, const int* in_sizes, int n_in, void* d_out, int out_size, void* d_ws, size_t ws_size, hipStream_t stream) {
    static int grid_blocks = 0;
    if (grid_blocks == 0) {
        if (n_in != 21 || out_size != NLAT * D || ws_size < WS_END) { fprintf(stderr, "kernel_launch: unexpected shapes (n_in %d out %d ws %zu need %zu)\n", n_in, out_size, ws_size, (size_t)WS_END); grid_blocks = -1; return; }
        int dev = 0, cus = 0, per_cu = 0;
        hipGetDevice(&dev); hipDeviceGetAttribute(&cus, hipDeviceAttributeMultiprocessorCount, dev);
        if (hipFuncSetAttribute((const void*)fwd_megakernel, hipFuncAttributeMaxDynamicSharedMemorySize, LDS_BYTES) != hipSuccess) { fprintf(stderr, "kernel_launch: hipFuncSetAttribute failed\n"); grid_blocks = -1; return; }
        hipOccupancyMaxActiveBlocksPerMultiprocessor(&per_cu, (const void*)fwd_megakernel, 512, LDS_BYTES);
        if (per_cu < 1) { fprintf(stderr, "kernel_launch: occupancy query says %d blocks per CU\n", per_cu); per_cu = 1; }
        (void)hipGetLastError();
        grid_blocks = cus;
    }
    if (grid_blocks < 0) return;
    if (hipMemsetAsync((unsigned char*)d_ws + OFF_BAR, 0, XCD_BAR_WORDS * 4, stream) != hipSuccess) { fprintf(stderr, "kernel_launch: memset failed\n"); return; }
    Params p{};
    const float** pp = (const float**)&p;
    for (int i = 0; i < 21; ++i) pp[i] = (const float*)d_in[i];
    p.out = (float*)d_out; p.ws = (unsigned char*)d_ws;
    void* args[] = {&p};
    hipError_t e = hipLaunchCooperativeKernel((const void*)fwd_megakernel, dim3(grid_blocks), dim3(512), args, LDS_BYTES, stream);
    if (e != hipSuccess) fprintf(stderr, "cooperative launch failed: %s (grid %d)\n", hipGetErrorString(e), grid_blocks);
}
```
